# Optimizing an MI355X kernel written in HIP

```python
import math
import jax, jax.numpy as jnp
from jax import lax
import numpy as np

D_MODEL = 1024
BATCH = 16
SEQ = 256
DEPTH = 4
DEC_BATCH = 4
DEC_SEQ = 1024
PAST_LEN = 256

GRID_W = 64
N_MIXERS = 3
N_GMLP_LAYERS = (DEPTH + 2) // 3
N_ATTN_LAYERS = (DEPTH + 1) // 3
N_SSM_LAYERS = DEPTH // 3
N_MOD = 9
D_FF = 2816
EPS = 1e-6
GMLP_HALF = 3 * D_MODEL
GMLP_GROUPS = 8
GMLP_GROUP_DIM = GMLP_HALF // GMLP_GROUPS
CHUNK = 128
HEAD_DIM = 64
N_Q_HEADS = D_MODEL // HEAD_DIM
N_KV_HEADS = 4
Q_PER_KV = N_Q_HEADS // N_KV_HEADS
Q_DIM = N_Q_HEADS * HEAD_DIM
KV_DIM = N_KV_HEADS * HEAD_DIM
WINDOW = 128
ATTN_BLOCK = 128
ATTN_SCALE = HEAD_DIM ** -0.5
ROPE_BASE = 10000.0
ROT_PAIRS = HEAD_DIM // 4
NEG_INF = -1e30
SSM_INNER = 2 * D_MODEL
SSM_HEAD_DIM = 64
SSM_HEADS = SSM_INNER // SSM_HEAD_DIM
SSM_GROUPS = 4
SSM_STATE = 128
SSM_CONV = 3
SSM_CHUNK = 128
SSM_GN = SSM_GROUPS * SSM_STATE
SSM_CONV_DIM = SSM_INNER + 2 * SSM_GN
SSM_IN_DIM = SSM_INNER + SSM_CONV_DIM + 2 * SSM_HEADS

kernel_name = 'hybrid_diffusion_prefix_trunk_step'


def rms_norm(x, g):
    xf = x.astype(jnp.float32)
    y = xf * lax.rsqrt(jnp.mean(xf * xf, axis=-1, keepdims=True) + EPS)
    return (y * g.astype(jnp.float32)).astype(x.dtype)


def layer_norm(x, g, b):
    xf = x.astype(jnp.float32)
    mu = jnp.mean(xf, axis=-1, keepdims=True)
    xc = xf - mu
    var = jnp.mean(xc * xc, axis=-1, keepdims=True)
    return (xc * lax.rsqrt(var + EPS) * g.astype(jnp.float32) + b.astype(jnp.float32)).astype(x.dtype)


def modulation(cond, w, b):
    return (jax.nn.silu(cond) @ w + b).reshape(cond.shape[0], N_MOD, D_MODEL)


def adaln(x, g, shift, scale):
    return rms_norm(x, g) * (1 + scale[:, None]) + shift[:, None]


def swiglu(h, w_in, w_out):
    gu = h @ w_in
    return (jax.nn.silu(gu[..., :D_FF]) * gu[..., D_FF:]) @ w_out


def chunk_mlp(h, w_in, ln_g, ln_b, w_s, b_s, w_out):
    b, n, _ = h.shape
    uv = jax.nn.gelu(h @ w_in, approximate=False)
    u, v = uv[..., :GMLP_HALF], uv[..., GMLP_HALF:]
    v = layer_norm(v, ln_g, ln_b).reshape(b, n // CHUNK, CHUNK, GMLP_GROUPS, GMLP_GROUP_DIM)
    v = jnp.einsum('gij,bcjgd->bcigd', w_s, v) + b_s.T[:, :, None]
    return (u * v.reshape(b, n, GMLP_HALF)) @ w_out


def axial_rope(t):
    n = t.shape[1]
    rows = n // GRID_W
    pos_r = jnp.repeat(jnp.arange(rows, dtype=jnp.float32), GRID_W)
    pos_c = (jnp.arange(n) % GRID_W).astype(jnp.float32)
    inv = ROPE_BASE ** (-jnp.arange(ROT_PAIRS, dtype=jnp.float32) / ROT_PAIRS)
    bshape = (1, n) + (1,) * (t.ndim - 3) + (ROT_PAIRS,)
    tf = t.astype(jnp.float32)

    def rot(x, pos):
        ang = (pos[:, None] * inv).reshape(bshape)
        cos, sin = jnp.cos(ang), jnp.sin(ang)
        x1, x2 = x[..., :ROT_PAIRS], x[..., ROT_PAIRS:]
        return jnp.concatenate([x1 * cos - x2 * sin, x2 * cos + x1 * sin], axis=-1)

    half = HEAD_DIM // 2
    return jnp.concatenate([rot(tf[..., :half], pos_r), rot(tf[..., half:], pos_c)], axis=-1).astype(t.dtype)


def project_qkv(h, w_qkv):
    b, n, _ = h.shape
    qkv = h @ w_qkv
    q = qkv[..., :Q_DIM].reshape(b, n, N_KV_HEADS, Q_PER_KV, HEAD_DIM)
    k = qkv[..., Q_DIM:Q_DIM + KV_DIM].reshape(b, n, N_KV_HEADS, HEAD_DIM)
    v = qkv[..., Q_DIM + KV_DIM:].reshape(b, n, N_KV_HEADS, HEAD_DIM)
    return q, k, v


def sink_probs(logits, sinks):
    sink = jnp.broadcast_to(sinks.astype(jnp.float32)[None, :, :, None, None], logits.shape[:-1] + (1,))
    return jax.nn.softmax(jnp.concatenate([logits, sink], axis=-1), axis=-1)[..., :-1]


def attn_context(h, w_qkv, sinks, w_out):
    b, s, _ = h.shape
    q, k, v = project_qkv(h, w_qkv)
    nb = s // ATTN_BLOCK
    qb = jnp.moveaxis(q.reshape(b, nb, ATTN_BLOCK, N_KV_HEADS, Q_PER_KV, HEAD_DIM), 1, 0)
    sk = sinks.reshape(N_KV_HEADS, Q_PER_KV)

    def block(qi):
        logits = jnp.einsum('bqhgd,bkhd->bhgqk', qi, k).astype(jnp.float32) * ATTN_SCALE
        p = sink_probs(logits, sk).astype(v.dtype)
        return jnp.einsum('bhgqk,bkhd->bqhgd', p, v)

    o = jnp.moveaxis(lax.map(block, qb), 0, 1).reshape(b, s, Q_DIM)
    return o @ w_out, k, v


def attn_latent(h, w_qkv, sinks, w_out, ck, cv):
    b, n, _ = h.shape
    q, k, v = project_qkv(h, w_qkv)
    q, k = axial_rope(q), axial_rope(k)
    nb = n // ATTN_BLOCK
    pad = ((0, 0), (ATTN_BLOCK, ATTN_BLOCK), (0, 0), (0, 0))
    kp, vp = jnp.pad(k, pad), jnp.pad(v, pad)
    qb = jnp.moveaxis(q.reshape(b, nb, ATTN_BLOCK, N_KV_HEADS, Q_PER_KV, HEAD_DIM), 1, 0)
    sk = sinks.reshape(N_KV_HEADS, Q_PER_KV)
    span = 3 * ATTN_BLOCK

    def block(args):
        i, qi = args
        start = i * ATTN_BLOCK
        kb = lax.dynamic_slice_in_dim(kp, start, span, axis=1)
        vb = lax.dynamic_slice_in_dim(vp, start, span, axis=1)
        qpos = start + jnp.arange(ATTN_BLOCK)
        kpos = start - ATTN_BLOCK + jnp.arange(span)
        valid = (kpos >= 0) & (kpos < n) & (jnp.abs(qpos[:, None] - kpos[None, :]) <= WINDOW)
        s_loc = jnp.einsum('bqhgd,bkhd->bhgqk', qi, kb).astype(jnp.float32) * ATTN_SCALE
        s_loc = jnp.where(valid, s_loc, NEG_INF)
        s_ctx = jnp.einsum('bqhgd,bkhd->bhgqk', qi, ck).astype(jnp.float32) * ATTN_SCALE
        p = sink_probs(jnp.concatenate([s_loc, s_ctx], axis=-1), sk).astype(vb.dtype)
        return (jnp.einsum('bhgqk,bkhd->bqhgd', p[..., :span], vb)
                + jnp.einsum('bhgqk,bkhd->bqhgd', p[..., span:], cv))

    o = lax.map(block, (jnp.arange(nb), qb))
    o = jnp.moveaxis(o, 0, 1).reshape(b, n, Q_DIM)
    return o @ w_out


def dwconv(x, w, b):
    ch = x.shape[-1]
    padw = SSM_CONV // 2
    y = lax.conv_general_dilated(x, w[:, None, :], window_strides=(1,), padding=[(padw, padw)],
                                 dimension_numbers=('NWC', 'WIO', 'NWC'), feature_group_count=ch)
    return y + b


def ssd_scan(x, dt, a, bm, cm, h0):
    b, n, h, p = x.shape
    g, s = bm.shape[2], bm.shape[3]
    hg, L = h // g, SSM_CHUNK
    c = n // L
    f32 = jnp.float32
    x = x.astype(f32).reshape(b, c, L, g, hg, p)
    dt = dt.reshape(b, c, L, g, hg)
    bm = bm.astype(f32).reshape(b, c, L, g, s)
    cm = cm.astype(f32).reshape(b, c, L, g, s)
    acum = jnp.cumsum(dt * a.reshape(g, hg), axis=2)
    xdt = x * dt[..., None]
    tril = jnp.tril(jnp.ones((L, L), dtype=bool))[:, :, None, None]
    seg = acum[:, :, :, None] - acum[:, :, None, :]
    decay = jnp.exp(jnp.where(tril, seg, -jnp.inf))
    w = jnp.einsum('bcign,bcjgn->bcijg', cm, bm)[..., None] * decay
    y_diag = jnp.einsum('bcijgh,bcjghp->bcighp', w, xdt)
    to_end = jnp.exp(acum[:, :, -1:] - acum)
    states = jnp.einsum('bcjgn,bcjghp->bcghpn', bm, xdt * to_end[..., None])
    chunk_decay = jnp.exp(acum[:, :, -1])

    def step(hs, inp):
        dec, st = inp
        return dec[..., None, None] * hs + st, hs

    h_final, h_prev = lax.scan(step, h0.astype(f32).reshape(b, g, hg, p, s),
                               (jnp.moveaxis(chunk_decay, 1, 0), jnp.moveaxis(states, 1, 0)))
    h_prev = jnp.moveaxis(h_prev, 0, 1)
    y_off = jnp.einsum('bcign,bcghpn->bcighp', cm, h_prev) * jnp.exp(acum)[..., None]
    return (y_diag + y_off).reshape(b, n, h, p), h_final.reshape(b, h, p, s)


def ssm_mixer(h, w_in, conv_w, conv_b, dt_bias, a_log, d_skip, norm_g, w_out, h0):
    b, n, _ = h.shape
    zxbcdt = h @ w_in
    z = zxbcdt[..., :SSM_INNER]
    xbc = jax.nn.silu(dwconv(zxbcdt[..., SSM_INNER:SSM_INNER + SSM_CONV_DIM], conv_w, conv_b))
    dt = zxbcdt[..., SSM_INNER + SSM_CONV_DIM:].reshape(b, n, 2, SSM_HEADS).astype(jnp.float32)
    dt = jax.nn.softplus(dt + dt_bias.astype(jnp.float32))
    a = -jnp.exp(a_log.astype(jnp.float32))
    xs = xbc[..., :SSM_INNER].reshape(b, n, SSM_HEADS, SSM_HEAD_DIM)
    bm = xbc[..., SSM_INNER:SSM_INNER + SSM_GN].reshape(b, n, SSM_GROUPS, SSM_STATE)
    cm = xbc[..., SSM_INNER + SSM_GN:].reshape(b, n, SSM_GROUPS, SSM_STATE)
    y_f, s_f = ssd_scan(xs, dt[:, :, 0], a[0], bm, cm, h0[:, 0])

    def rev(t):
        return jnp.flip(t, axis=1)

    y_b, s_b = ssd_scan(rev(xs), rev(dt[:, :, 1]), a[1], rev(bm), rev(cm), h0[:, 1])
    y = y_f + rev(y_b) + d_skip.astype(jnp.float32)[:, None] * xs.astype(jnp.float32)
    y = y.reshape(b, n, SSM_INNER) * jax.nn.silu(z.astype(jnp.float32))
    y = rms_norm(y, norm_g).astype(h.dtype)
    return y @ w_out, jnp.stack([s_f, s_b], axis=1)


def trunk(x, cond, W, ctx_k, ctx_v, ctx_state):
    latent = ctx_k is not None
    new_k, new_v, new_s = [], [], []
    for i in range(DEPTH):
        mod = modulation(cond, W['w_mod'][i], W['b_mod'][i])
        g = W['norm_g'][i]
        f = swiglu(adaln(x, g[0], mod[:, 0], mod[:, 1]), W['ffn_in'][i, 0], W['ffn_out'][i, 0])
        x = x + 0.5 * mod[:, 2][:, None] * rms_norm(f, g[1])
        h = adaln(x, g[2], mod[:, 3], mod[:, 4])
        kind, j = i % N_MIXERS, i // N_MIXERS
        if kind == 0:
            m = chunk_mlp(h, W['gmlp_in'][j], W['gmlp_ln_g'][j], W['gmlp_ln_b'][j],
                          W['gmlp_ws'][j], W['gmlp_bs'][j], W['gmlp_out'][j])
        elif kind == 1:
            if latent:
                m = attn_latent(h, W['attn_qkv'][j], W['attn_sink'][j], W['attn_out'][j],
                                ctx_k[:, j], ctx_v[:, j])
            else:
                m, k, v = attn_context(h, W['attn_qkv'][j], W['attn_sink'][j], W['attn_out'][j])
                new_k.append(k)
                new_v.append(v)
        else:
            if latent:
                h0 = ctx_state[:, j]
            else:
                h0 = jnp.zeros((x.shape[0], 2, SSM_HEADS, SSM_HEAD_DIM, SSM_STATE), jnp.float32)
            m, s = ssm_mixer(h, W['ssm_in'][j], W['ssm_conv_w'][j], W['ssm_conv_b'][j],
                             W['ssm_dt_bias'][j], W['ssm_a_log'][j], W['ssm_d'][j],
                             W['ssm_norm'][j], W['ssm_out'][j], h0)
            if not latent:
                new_s.append(s)
        x = x + mod[:, 5][:, None] * rms_norm(m, g[3])
        f = swiglu(adaln(x, g[4], mod[:, 6], mod[:, 7]), W['ffn_in'][i, 1], W['ffn_out'][i, 1])
        x = x + 0.5 * mod[:, 8][:, None] * rms_norm(f, g[5])
    return x, new_k, new_v, new_s


def setup_inputs(seed: int = 0) -> dict:
    key = jax.random.key(seed)
    ks = jax.random.split(key, 32)
    D = D_MODEL

    def nrm(i, shape, scale=1.0):
        return jax.random.normal(ks[i], shape, jnp.float32) * scale

    dt0 = jnp.exp(jax.random.uniform(ks[25], (N_SSM_LAYERS, 2, SSM_HEADS), jnp.float32,
                                     math.log(1e-3), math.log(1e-1)))
    return {
        'x_prompt': nrm(0, (BATCH, SEQ, D)),
        'x_sample': nrm(1, (DEC_BATCH, DEC_SEQ, D)),
        'cache_k': nrm(2, (DEC_BATCH, N_ATTN_LAYERS, PAST_LEN, N_KV_HEADS, HEAD_DIM)),
        'cache_v': nrm(3, (DEC_BATCH, N_ATTN_LAYERS, PAST_LEN, N_KV_HEADS, HEAD_DIM)),
        'state_ssm': nrm(4, (DEC_BATCH, N_SSM_LAYERS, 2, SSM_HEADS, SSM_HEAD_DIM, SSM_STATE), 0.1),
        'c': nrm(5, (DEC_BATCH, D)),
        'c_ctx': nrm(6, (D,)),
        'w_mod': nrm(7, (DEPTH, D, N_MOD * D), D ** -0.5),
        'b_mod': nrm(8, (DEPTH, N_MOD * D), 0.02),
        'norm_g': 1.0 + nrm(9, (DEPTH, 6, D), 0.02),
        'ffn_in': nrm(10, (DEPTH, 2, D, 2 * D_FF), D ** -0.5),
        'ffn_out': nrm(11, (DEPTH, 2, D_FF, D), D_FF ** -0.5),
        'gmlp_in': nrm(12, (N_GMLP_LAYERS, D, 2 * GMLP_HALF), D ** -0.5),
        'gmlp_ln_g': 1.0 + nrm(13, (N_GMLP_LAYERS, GMLP_HALF), 0.02),
        'gmlp_ln_b': nrm(14, (N_GMLP_LAYERS, GMLP_HALF), 0.02),
        'gmlp_ws': nrm(15, (N_GMLP_LAYERS, GMLP_GROUPS, CHUNK, CHUNK), CHUNK ** -0.5),
        'gmlp_bs': 1.0 + nrm(16, (N_GMLP_LAYERS, GMLP_GROUPS, CHUNK), 0.02),
        'gmlp_out': nrm(17, (N_GMLP_LAYERS, GMLP_HALF, D), GMLP_HALF ** -0.5),
        'attn_qkv': nrm(18, (N_ATTN_LAYERS, D, Q_DIM + 2 * KV_DIM), D ** -0.5),
        'attn_sink': nrm(19, (N_ATTN_LAYERS, N_Q_HEADS), 0.5),
        'attn_out': nrm(20, (N_ATTN_LAYERS, Q_DIM, D), Q_DIM ** -0.5),
        'ssm_in': nrm(21, (N_SSM_LAYERS, D, SSM_IN_DIM), D ** -0.5),
        'ssm_conv_w': nrm(22, (N_SSM_LAYERS, SSM_CONV, SSM_CONV_DIM), SSM_CONV ** -0.5),
        'ssm_conv_b': nrm(23, (N_SSM_LAYERS, SSM_CONV_DIM), 0.02),
        'ssm_dt_bias': dt0 + jnp.log(-jnp.expm1(-dt0)),
        'ssm_a_log': jnp.log(jax.random.uniform(ks[26], (N_SSM_LAYERS, 2, SSM_HEADS), jnp.float32, 1.0, 16.0)),
        'ssm_d': 1.0 + nrm(27, (N_SSM_LAYERS, SSM_HEADS), 0.02),
        'ssm_norm': 1.0 + nrm(28, (N_SSM_LAYERS, SSM_INNER), 0.02),
        'ssm_out': nrm(29, (N_SSM_LAYERS, SSM_INNER, D), SSM_INNER ** -0.5),
    }


def reference(x_prompt, x_sample, cache_k, cache_v, state_ssm, c, c_ctx,
              w_mod, b_mod, norm_g, ffn_in, ffn_out,
              gmlp_in, gmlp_ln_g, gmlp_ln_b, gmlp_ws, gmlp_bs, gmlp_out,
              attn_qkv, attn_sink, attn_out,
              ssm_in, ssm_conv_w, ssm_conv_b, ssm_dt_bias, ssm_a_log, ssm_d, ssm_norm, ssm_out):
    W = {
        'w_mod': w_mod, 'b_mod': b_mod, 'norm_g': norm_g, 'ffn_in': ffn_in, 'ffn_out': ffn_out,
        'gmlp_in': gmlp_in, 'gmlp_ln_g': gmlp_ln_g, 'gmlp_ln_b': gmlp_ln_b, 'gmlp_ws': gmlp_ws,
        'gmlp_bs': gmlp_bs, 'gmlp_out': gmlp_out,
        'attn_qkv': attn_qkv, 'attn_sink': attn_sink, 'attn_out': attn_out,
        'ssm_in': ssm_in, 'ssm_conv_w': ssm_conv_w, 'ssm_conv_b': ssm_conv_b,
        'ssm_dt_bias': ssm_dt_bias, 'ssm_a_log': ssm_a_log, 'ssm_d': ssm_d,
        'ssm_norm': ssm_norm, 'ssm_out': ssm_out,
    }
    y_prompt, ks_new, vs_new, ss_new = trunk(x_prompt, c_ctx[None, :], W, None, None, None)
    y_sample, _, _, _ = trunk(x_sample, c, W, cache_k, cache_v, state_ssm)
    new_cache_k = jnp.stack(ks_new, axis=1)
    new_cache_v = jnp.stack(vs_new, axis=1)
    new_state_ssm = jnp.stack(ss_new, axis=1)
    return (y_prompt, y_sample, new_cache_k, new_cache_v, new_state_ssm)
```

```cpp
#include <hip/hip_runtime.h>
#include <hip/hip_cooperative_groups.h>
#include <cstdio>
#include <cstdint>
namespace cg = cooperative_groups;

#ifndef EXTRA_SYNCS
#define EXTRA_SYNCS 0
#endif
#ifndef REPEAT_MASK
#define REPEAT_MASK 0
#endif
#ifndef ONE_LAUNCH
#define ONE_LAUNCH 1
#endif

typedef unsigned short bf16_t;
using bf16x8 = __attribute__((ext_vector_type(8))) short;
using f32x4  = __attribute__((ext_vector_type(4))) float;
using f32x16 = __attribute__((ext_vector_type(16))) float;

#define NTHR 512
#define HALF_SMEM 70656
#define SMEM_BYTES (147456 + 16)

__device__ __forceinline__ bf16_t f2bf(float f) {
  unsigned u = __float_as_uint(f);
  u += 0x7fffu + ((u >> 16) & 1u);
  return (bf16_t)(u >> 16);
}
__device__ __forceinline__ unsigned cvt_pk_bf16(float lo, float hi) {
  unsigned r;
  asm("v_cvt_pk_bf16_f32 %0, %1, %2" : "=v"(r) : "v"(lo), "v"(hi));
  return r;
}
__device__ __forceinline__ bf16_t f2bf_hw(float f) { return (bf16_t)(cvt_pk_bf16(f, f) & 0xffffu); }
__device__ __forceinline__ float bf2f(bf16_t b) { return __uint_as_float(((unsigned)b) << 16); }
__device__ __forceinline__ unsigned pack2(float a, float b) { return (unsigned)f2bf(a) | ((unsigned)f2bf(b) << 16); }
__device__ __forceinline__ float lo_f(unsigned w) { return __uint_as_float(w << 16); }
__device__ __forceinline__ float hi_f(unsigned w) { return __uint_as_float(w & 0xffff0000u); }
__device__ __forceinline__ float silu_f(float x) { return __fdividef(x, 1.f + __expf(-x)); }
__device__ __forceinline__ float gelu_f(float x) {
  const float z = fabsf(x) * 0.70710678118654752f;
  const float t = __fdividef(1.f, 1.f + 0.3275911f * z);
  const float poly = t * (0.254829592f + t * (-0.284496736f + t * (1.421413741f + t * (-1.453152027f + t * 1.061405429f))));
  const float e = 1.f - poly * __expf(-z * z);
  return 0.5f * x * (1.f + copysignf(e, x));
}

__device__ __forceinline__ int opaque_tid(const int wvs) {
  int t = (wvs << 6) | (int)__builtin_amdgcn_mbcnt_hi(~0u, __builtin_amdgcn_mbcnt_lo(~0u, 0u));
  asm volatile("" : "+v"(t));
  return t;
}

__device__ __forceinline__ float4 nt_load4(const float* p) {
  typedef float v4f __attribute__((ext_vector_type(4)));
  v4f t = __builtin_nontemporal_load((const v4f*)p);
  return make_float4(t.x, t.y, t.z, t.w);
}

struct Params {
  const float *x_prompt, *x_sample, *cache_k, *cache_v, *state_ssm, *c, *c_ctx;
  const float *w_mod, *b_mod, *norm_g, *ffn_in, *ffn_out;
  const float *gmlp_in, *gmlp_ln_g, *gmlp_ln_b, *gmlp_ws, *gmlp_bs, *gmlp_out;
  const float *attn_qkv, *attn_sink, *attn_out;
  const float *ssm_in, *ssm_conv_w, *ssm_conv_b, *ssm_dt_bias, *ssm_a_log, *ssm_d, *ssm_norm, *ssm_out;
  float* out;
  bf16_t *wt_ffn_in, *wt_ffn_out, *wt_gmlp_in, *wt_gmlp_out, *wt_qkv, *wt_ao, *wt_ssm_in, *wt_ssm_out, *ws_bf;
  float *mod, *x, *f, *stats;
  bf16_t *h, *hid;
  char* R;
  unsigned* bar;
};

#define R_U_OFF      0ull
#define R_VT_OFF     50331648ull
#define R_GATED_OFF  100663296ull
#define R_QKV_OFF    0ull
#define R_AO_OFF     25165824ull
#define R_ZX_OFF     0ull
#define R_DT_OFF     83886080ull
#define R_XC_OFF     85983232ull
#define R_Y_OFF      136314880ull
#define R_BYTES      203423744ull

struct TJob { const float* src; bf16_t* dst; int K, N, nmat, perm, dstRows; };

__device__ __forceinline__ TJob get_job(const Params& p, int j) {
  TJob t;
  switch (j) {
    case 0: t.src = p.ffn_in;   t.dst = p.wt_ffn_in;   t.K = 1024; t.N = 5632; t.nmat = 8; t.perm = 1; t.dstRows = 5632; break;
    case 1: t.src = p.ffn_out;  t.dst = p.wt_ffn_out;  t.K = 2816; t.N = 1024; t.nmat = 8; t.perm = 0; t.dstRows = 1024; break;
    case 2: t.src = p.gmlp_in;  t.dst = p.wt_gmlp_in;  t.K = 1024; t.N = 6144; t.nmat = 2; t.perm = 0; t.dstRows = 6144; break;
    case 3: t.src = p.gmlp_out; t.dst = p.wt_gmlp_out; t.K = 3072; t.N = 1024; t.nmat = 2; t.perm = 0; t.dstRows = 1024; break;
    case 4: t.src = p.attn_qkv; t.dst = p.wt_qkv;      t.K = 1024; t.N = 1536; t.nmat = 1; t.perm = 0; t.dstRows = 1536; break;
    case 5: t.src = p.attn_out; t.dst = p.wt_ao;       t.K = 1024; t.N = 1024; t.nmat = 1; t.perm = 0; t.dstRows = 1024; break;
    case 6: t.src = p.ssm_in;   t.dst = p.wt_ssm_in;   t.K = 1024; t.N = 5184; t.nmat = 1; t.perm = 0; t.dstRows = 5376; break;
    default: t.src = p.ssm_out; t.dst = p.wt_ssm_out;  t.K = 2048; t.N = 1024; t.nmat = 1; t.perm = 0; t.dstRows = 1024; break;
  }
  return t;
}

__device__ void prep_phase(const Params& p, char* smem, const int wvs) {
  const int tid = opaque_tid(wvs), half = tid >> 8, tl = tid & 255, lane = tid & 63, wid = tl >> 6;
  const int vb = blockIdx.x * 2 + half, nvb = gridDim.x * 2;
  char* hsm = smem + half * HALF_SMEM;
  float* sc = (float*)smem;
  float* red = sc + 8192;
  for (int i = tid; i < 5120; i += NTHR) {
    int ci = i >> 10, k = i & 1023;
    float v = ci == 0 ? p.c_ctx[k] : p.c[(ci - 1) * 1024 + k];
    sc[k * 8 + ci] = v / (1.f + expf(-v));
  }
  __syncthreads();
  for (int u = blockIdx.x; u < 256; u += gridDim.x) {
    const int l = u >> 6, n0 = (u & 63) * 144, w8 = tid >> 6;
    float4 a0 = make_float4(0.f, 0.f, 0.f, 0.f), a1 = a0, a2 = a0, a3 = a0, a4 = a0;
    if (lane < 36) {
      const float* wp = p.w_mod + ((size_t)l * 1024 + w8 * 128) * 9216 + n0 + lane * 4;
      const float* s0 = sc + w8 * 128 * 8;
#pragma unroll 8
      for (int k = 0; k < 128; ++k) {
        const float4 wv = nt_load4(wp + (size_t)k * 9216);
        const float4 s4 = *(const float4*)(s0 + k * 8);
        const float s5 = s0[k * 8 + 4];
        a0.x += s4.x * wv.x; a0.y += s4.x * wv.y; a0.z += s4.x * wv.z; a0.w += s4.x * wv.w;
        a1.x += s4.y * wv.x; a1.y += s4.y * wv.y; a1.z += s4.y * wv.z; a1.w += s4.y * wv.w;
        a2.x += s4.z * wv.x; a2.y += s4.z * wv.y; a2.z += s4.z * wv.z; a2.w += s4.z * wv.w;
        a3.x += s4.w * wv.x; a3.y += s4.w * wv.y; a3.z += s4.w * wv.z; a3.w += s4.w * wv.w;
        a4.x += s5 * wv.x; a4.y += s5 * wv.y; a4.z += s5 * wv.z; a4.w += s5 * wv.w;
      }
      float* rp = red + (w8 * 5) * 144 + lane * 4;
      *(float4*)(rp) = a0; *(float4*)(rp + 144) = a1; *(float4*)(rp + 288) = a2; *(float4*)(rp + 432) = a3; *(float4*)(rp + 576) = a4;
    }
    __syncthreads();
    for (int i = tid; i < 720; i += NTHR) {
      const int ci = i / 144, col = i - ci * 144;
      float sum = p.b_mod[l * 9216 + n0 + col];
#pragma unroll
      for (int w = 0; w < 8; ++w) sum += red[(w * 5 + ci) * 144 + col];
      p.mod[((size_t)l * 5 + ci) * 9216 + n0 + col] = sum;
    }
    __syncthreads();
  }
  for (int base = blockIdx.x * NTHR; base < 192 * 1024 / 2; base += gridDim.x * NTHR) {
    int i = base + tid;
    if (i < 192 * 1024 / 2) ((unsigned*)(p.wt_ssm_in + 5184 * 1024))[i] = 0u;
  }
  for (int base = blockIdx.x * NTHR; base < 2 * 8 * 128 * 128 / 2; base += gridDim.x * NTHR) {
    int i = base + tid;
    if (i < 2 * 8 * 128 * 128 / 2) {
      float2 v = ((const float2*)p.gmlp_ws)[i];
      ((unsigned*)p.ws_bf)[i] = pack2(v.x, v.y);
    }
  }
  float* sm = (float*)hsm;
  __syncthreads();
#pragma unroll 1
  for (int j = 0; j < 8; ++j) {
    TJob tj = get_job(p, j);
    const int kt_n = tj.K >> 6, nt_n = (tj.N + 127) >> 7, tpm = kt_n * nt_n, ntl = tpm * tj.nmat;
    float4 v[8];
    auto tile_load = [&](int t) {
      int mat = t / tpm, r = t - mat * tpm, nt = r / kt_n, kt = r - nt * kt_n;
      const int col = nt * 128 + (tl & 31) * 4;
      const float* src = tj.src + (size_t)mat * tj.K * tj.N + (size_t)(kt * 64) * tj.N + col;
      if (col < tj.N) {
#pragma unroll
        for (int i = 0; i < 8; ++i) v[i] = nt_load4(src + (size_t)((tl >> 5) + 8 * i) * tj.N);
      }
    };
    {
      const int t = blockIdx.x * 2 + half;
      if (t < ntl) tile_load(t);
    }
    for (int t0 = blockIdx.x * 2; t0 < ntl; t0 += nvb) {
      const int t = t0 + half;
      const bool act = t < ntl;
      int mat = t / tpm, r = t - mat * tpm, nt = r / kt_n, kt = r - nt * kt_n;
      if (act) {
#pragma unroll
        for (int i = 0; i < 8; ++i) {
          int k = (tl >> 5) + 8 * i, cc = (tl & 31) * 4;
          sm[k * 129 + cc] = v[i].x; sm[k * 129 + cc + 1] = v[i].y; sm[k * 129 + cc + 2] = v[i].z; sm[k * 129 + cc + 3] = v[i].w;
        }
      }
      __syncthreads();
      if (t + nvb < ntl) tile_load(t + nvb);
      if (act) {
        int n = tl >> 1, ks = (tl & 1) * 32;
        int dn = nt * 128 + n;
        if (dn < tj.N) {
          unsigned w[16];
#pragma unroll
          for (int e = 0; e < 16; ++e) w[e] = pack2(sm[(ks + 2 * e) * 129 + n], sm[(ks + 2 * e + 1) * 129 + n]);
          if (tj.perm) dn = dn < 2816 ? ((dn >> 5) * 64 + (dn & 31)) : ((((dn - 2816) >> 5) * 64) + 32 + ((dn - 2816) & 31));
          uint4* dp = (uint4*)(tj.dst + ((size_t)mat * tj.dstRows + dn) * tj.K + kt * 64 + ks);
          dp[0] = make_uint4(w[0], w[1], w[2], w[3]);
          dp[1] = make_uint4(w[4], w[5], w[6], w[7]);
          dp[2] = make_uint4(w[8], w[9], w[10], w[11]);
          dp[3] = make_uint4(w[12], w[13], w[14], w[15]);
        }
      }
      __syncthreads();
    }
  }
}

__device__ __forceinline__ void gemm_half(const bf16_t* Ag, int lda, const bf16_t* Bg, int ldb, int K, char* smem,
                                          f32x4 (&acc)[4][4], const int tid) {
  const int lane = tid & 63, wid = tid >> 6, wr = wid >> 1, wc = wid & 1, fr = lane & 15, fq = lane >> 4;
#pragma unroll
  for (int m = 0; m < 4; ++m)
#pragma unroll
    for (int n = 0; n < 4; ++n) acc[m][n] = f32x4{0.f, 0.f, 0.f, 0.f};
  const int r0 = tid >> 3, pos = tid & 7;
  const int cg = (pos ^ ((r0 >> 1) & 7)) * 8;
  const bf16_t* ap = Ag + (size_t)r0 * lda + cg;
  const bf16_t* bp = Bg + (size_t)r0 * ldb + cg;
  const int nk = K >> 6;
  auto stage = [&](int kt, int buf) {
    char* SA = smem + buf * 32768;
    char* SB = SA + 16384;
#pragma unroll
    for (int i = 0; i < 4; ++i) {
      __builtin_amdgcn_global_load_lds((const unsigned*)(ap + (size_t)(32 * i) * lda + kt * 64),
                                       (__attribute__((address_space(3))) unsigned*)(SA + tid * 16 + i * 4096), 16, 0, 0);
      __builtin_amdgcn_global_load_lds((const unsigned*)(bp + (size_t)(32 * i) * ldb + kt * 64),
                                       (__attribute__((address_space(3))) unsigned*)(SB + tid * 16 + i * 4096), 16, 0, 0);
    }
  };
  const int swz = (fr >> 1) & 7;
  const int aoff = (wr * 64 + fr) * 128, boff = (wc * 64 + fr) * 128;
  const int c0 = ((fq) ^ swz) * 16, c1 = ((4 + fq) ^ swz) * 16;
  stage(0, 0);
#pragma unroll 1
  for (int kt = 0; kt < nk; ++kt) {
    asm volatile("s_waitcnt vmcnt(0)" ::: "memory");
    __syncthreads();
    if (kt + 1 < nk) stage(kt + 1, (kt + 1) & 1);
    const char* SA = smem + (kt & 1) * 32768;
    const char* SB = SA + 16384;
    bf16x8 a[4][2], b[4][2];
#pragma unroll
    for (int m = 0; m < 4; ++m) { a[m][0] = *(const bf16x8*)(SA + aoff + m * 2048 + c0); a[m][1] = *(const bf16x8*)(SA + aoff + m * 2048 + c1); }
#pragma unroll
    for (int n = 0; n < 4; ++n) { b[n][0] = *(const bf16x8*)(SB + boff + n * 2048 + c0); b[n][1] = *(const bf16x8*)(SB + boff + n * 2048 + c1); }
#pragma unroll
    for (int kk = 0; kk < 2; ++kk)
#pragma unroll
      for (int m = 0; m < 4; ++m)
#pragma unroll
        for (int n = 0; n < 4; ++n) acc[m][n] = __builtin_amdgcn_mfma_f32_16x16x32_bf16(a[m][kk], b[n][kk], acc[m][n], 0, 0, 0);
  }
  __syncthreads();
}

template <int WM, int WN, int MT>
__device__ __forceinline__ void gemm_big(const bf16_t* Ag, int lda, const bf16_t* Bg, int ldb, int K, char* smem,
                                         f32x4 (&acc)[MT][4], const int tid) {
  constexpr int BMt = WM * MT * 16, BNt = WN * 64;
  constexpr int STAGE_BYTES = (BMt + BNt) * 128;
  const int lane = tid & 63, wid = tid >> 6, wr = wid / WN, wc = wid % WN, fr = lane & 15, fq = lane >> 4;
#pragma unroll
  for (int m = 0; m < MT; ++m)
#pragma unroll
    for (int n = 0; n < 4; ++n) acc[m][n] = f32x4{0.f, 0.f, 0.f, 0.f};
  const int r0 = tid >> 3, pos = tid & 7;
  const int cg = (pos ^ ((r0 >> 1) & 7)) * 8;
  const bf16_t* ap = Ag + (size_t)r0 * lda + cg;
  const bf16_t* bp = Bg + (size_t)r0 * ldb + cg;
  const int nk = K >> 6;
  auto stage = [&](int kt, int buf) {
    char* SA = smem + buf * STAGE_BYTES;
    char* SB = SA + BMt * 128;
#pragma unroll
    for (int i = 0; i < BMt / 64; ++i)
      __builtin_amdgcn_global_load_lds((const unsigned*)(ap + (size_t)(64 * i) * lda + kt * 64),
                                       (__attribute__((address_space(3))) unsigned*)(SA + tid * 16 + i * 8192), 16, 0, 0);
#pragma unroll
    for (int i = 0; i < BNt / 64; ++i)
      __builtin_amdgcn_global_load_lds((const unsigned*)(bp + (size_t)(64 * i) * ldb + kt * 64),
                                       (__attribute__((address_space(3))) unsigned*)(SB + tid * 16 + i * 8192), 16, 0, 0);
  };
  const int swz = (fr >> 1) & 7;
  const int aoff = (wr * MT * 16 + fr) * 128, boff = BMt * 128 + (wc * 64 + fr) * 128;
  const int c0 = ((fq) ^ swz) * 16, c1 = ((4 + fq) ^ swz) * 16;
  stage(0, 0);
#pragma unroll 1
  for (int kt = 0; kt < nk; ++kt) {
    asm volatile("s_waitcnt vmcnt(0)" ::: "memory");
    __syncthreads();
    if (kt + 1 < nk) stage(kt + 1, (kt + 1) & 1);
    const char* S = smem + (kt & 1) * STAGE_BYTES;
#pragma unroll
    for (int kk = 0; kk < 2; ++kk) {
      const int cc = kk ? c1 : c0;
      bf16x8 b[4], a[MT];
#pragma unroll
      for (int n = 0; n < 4; ++n) b[n] = *(const bf16x8*)(S + boff + n * 2048 + cc);
#pragma unroll
      for (int m = 0; m < MT; ++m) a[m] = *(const bf16x8*)(S + aoff + m * 2048 + cc);
#pragma unroll
      for (int m = 0; m < MT; ++m)
#pragma unroll
        for (int n = 0; n < 4; ++n) acc[m][n] = __builtin_amdgcn_mfma_f32_16x16x32_bf16(a[m], b[n], acc[m][n], 0, 0, 0);
    }
  }
  __syncthreads();
}

template <int WM, int WN, int MT>
__device__ __forceinline__ void gemm_issue01(const bf16_t* Ag, int lda, const bf16_t* Bg, int ldb, char* smem, const int tid) {
  constexpr int BMt = WM * MT * 16, BNt = WN * 64;
  constexpr int STG = (BMt + BNt) * 64;
  constexpr int GA = BMt / 128, GB = BNt / 128;
  const int r0 = tid >> 2, pos = tid & 3;
  const int cg = (pos ^ (((r0 >> 3) & 1) * 3)) * 8;
  const bf16_t* ap = Ag + (size_t)r0 * lda + cg;
  const bf16_t* bp = Bg + (size_t)r0 * ldb + cg;
#pragma unroll
  for (int kt = 0; kt < 2; ++kt) {
    char* SA = smem + kt * STG;
    char* SB = SA + BMt * 64;
#pragma unroll
    for (int i = 0; i < GA; ++i)
      __builtin_amdgcn_global_load_lds((const unsigned*)(ap + (size_t)(128 * i) * lda + kt * 32),
                                       (__attribute__((address_space(3))) unsigned*)(SA + tid * 16 + i * 8192), 16, 0, 0);
#pragma unroll
    for (int i = 0; i < GB; ++i)
      __builtin_amdgcn_global_load_lds((const unsigned*)(bp + (size_t)(128 * i) * ldb + kt * 32),
                                       (__attribute__((address_space(3))) unsigned*)(SB + tid * 16 + i * 8192), 16, 0, 0);
  }
}

template <int WM, int WN, int MT, bool PRE = false>
__device__ __forceinline__ void gemm_pipe(const bf16_t* Ag, int lda, const bf16_t* Bg, int ldb, int K, char* smem,
                                          f32x4 (&acc)[MT][4], const int tid) {
  constexpr int BMt = WM * MT * 16, BNt = WN * 64;
  constexpr int STG = (BMt + BNt) * 64;
  constexpr int GA = BMt / 128, GB = BNt / 128, G = GA + GB;
  const int lane = tid & 63, wid = tid >> 6, wr = wid / WN, wc = wid % WN, fr = lane & 15, fq = lane >> 4;
#pragma unroll
  for (int m = 0; m < MT; ++m)
#pragma unroll
    for (int n = 0; n < 4; ++n) acc[m][n] = f32x4{0.f, 0.f, 0.f, 0.f};
  const int r0 = tid >> 2, pos = tid & 3;
  const int cg = (pos ^ (((r0 >> 3) & 1) * 3)) * 8;
  const unsigned toffA = (unsigned)(r0 * lda + cg) * 2u, toffB = (unsigned)(r0 * ldb + cg) * 2u;
  auto stageA = [&](int kt) {
    char* SA = smem + (kt & 3) * STG;
#pragma unroll
    for (int i = 0; i < GA; ++i)
      __builtin_amdgcn_global_load_lds((const unsigned*)((const char*)Ag + ((size_t)(128 * i) * lda + kt * 32) * 2 + toffA),
                                       (__attribute__((address_space(3))) unsigned*)(SA + tid * 16 + i * 8192), 16, 0, 0);
  };
  auto stageB = [&](int kt) {
    char* SB = smem + (kt & 3) * STG + BMt * 64;
#pragma unroll
    for (int i = 0; i < GB; ++i)
      __builtin_amdgcn_global_load_lds((const unsigned*)((const char*)Bg + ((size_t)(128 * i) * ldb + kt * 32) * 2 + toffB),
                                       (__attribute__((address_space(3))) unsigned*)(SB + tid * 16 + i * 8192), 16, 0, 0);
  };
  auto stage = [&](int kt) { stageA(kt); stageB(kt); };
  const int cpos = (fq ^ (((fr >> 3) & 1) * 3)) * 16;
  const int aoff = (wr * MT * 16 + fr) * 64 + cpos, boff = BMt * 64 + (wc * 64 + fr) * 64 + cpos;
  const int nk = K >> 5;
#define GP_RDB(kt, B_)                                                                   \
  {                                                                                      \
    const char* S_ = smem + ((kt) & 3) * STG;                                            \
    _Pragma("unroll") for (int n = 0; n < 4; ++n) B_[n] = *(const bf16x8*)(S_ + boff + n * 1024);  \
  }
#define GP_RDA(kt, A_, mb)                                                               \
  {                                                                                      \
    const char* S_ = smem + ((kt) & 3) * STG;                                            \
    _Pragma("unroll") for (int m = 0; m < MH; ++m) A_[m] = *(const bf16x8*)(S_ + aoff + ((mb) + m) * 1024); \
  }
#define GP_MMA(A_, B_, mb)                                                               \
  {                                                                                      \
    _Pragma("unroll") for (int m = 0; m < MH; ++m)                                       \
      _Pragma("unroll") for (int n = 0; n < 4; ++n)                                      \
        acc[(mb) + m][n] = __builtin_amdgcn_mfma_f32_16x16x32_bf16(A_[m], B_[n], acc[(mb) + m][n], 0, 0, 0); \
  }
#define GP_STEP(kt, Bc, Bn)                                                              \
  {                                                                                      \
    GP_RDA(kt, ahi, MH);                                                                 \
    __builtin_amdgcn_sched_barrier(0);                                                   \
    GP_MMA(alo, Bc, 0);                                                                  \
    __builtin_amdgcn_sched_barrier(0);                                                   \
    if ((kt) + 2 < nk) stageB((kt) + 2);                          \
    if ((kt) + 1 < nk) {                                                                 \
      if ((kt) + 2 < nk) asm volatile("s_waitcnt vmcnt(%0)" ::"n"(G) : "memory");        \
      else asm volatile("s_waitcnt vmcnt(0)" ::: "memory");                              \
    }                                                                                    \
    __builtin_amdgcn_s_barrier();                                                        \
    if ((kt) + 1 < nk) { GP_RDB((kt) + 1, Bn); GP_RDA((kt) + 1, alo, 0); }               \
    __builtin_amdgcn_sched_barrier(0);                                                   \
    GP_MMA(ahi, Bc, MH);                                                                 \
    __builtin_amdgcn_sched_barrier(0);                                                   \
    if ((kt) + 3 < nk) stageA((kt) + 3);                          \
  }
  constexpr int MH = MT / 2;
  if constexpr (PRE) {
    __syncthreads();
    stageA(2);
    asm volatile("s_waitcnt vmcnt(%0)" ::"n"(GA) : "memory");
  } else {
    __syncthreads();
    stage(0); stage(1); stageA(2);
    asm volatile("s_waitcnt vmcnt(%0)" ::"n"(G + GA) : "memory");
  }
  __builtin_amdgcn_s_barrier();
  bf16x8 alo[MH], ahi[MH], b0[4], b1[4];
  GP_RDB(0, b0);
  GP_RDA(0, alo, 0);
#pragma unroll 1
  for (int kt = 0; kt < nk; kt += 2) {
    GP_STEP(kt, b0, b1);
    GP_STEP(kt + 1, b1, b0);
  }
#undef GP_RDB
#undef GP_RDA
#undef GP_MMA
#undef GP_STEP
  __syncthreads();
}

enum { EPI_SWIGLU = 0, EPI_F32, EPI_GELU_U, EPI_GELU_VT, EPI_SPATIAL, EPI_QKV, EPI_SSMIN, EPI_PART };

struct EA { void* o0; void* o1; const void* a0; const void* a1; int i0, i1, i2, i3; };

__device__ __forceinline__ void flush64_bf16(const bf16_t* S, bf16_t* g, size_t ld, int lane) {
#pragma unroll
  for (int it = 0; it < 8; ++it) {
    const int r = it * 8 + (lane >> 3), c = (lane & 7) * 8;
    *(uint4*)(g + (size_t)r * ld + c) = *(const uint4*)(S + r * 72 + c);
  }
}

template <int EPI, int WN, int MT>
__device__ __forceinline__ void gemm_epi(const Params& p, f32x4 (&acc)[MT][4], int row0, int col0, const EA& ea, const int tid,
                                         char* smem, const int wv) {
  const int lane = tid & 63, wid = tid >> 6, wr = wid / WN, wc = wid % WN, fr = lane & 15, fq = lane >> 4;
  const int rb = row0 + wr * (MT * 16) + fq * 4, cb = col0 + wc * 64 + fr;
  const int wrow0 = row0 + wr * (MT * 16), wcol0 = col0 + wc * 64;
  __builtin_amdgcn_sched_barrier(0);
  if constexpr (EPI == EPI_SWIGLU) {
    bf16_t* hid = (bf16_t*)ea.o0;
    bf16_t* S = (bf16_t*)(smem + 65536 + wv * (MT * 16 * 80));
#pragma unroll
    for (int m = 0; m < MT; ++m)
#pragma unroll
      for (int n = 0; n < 2; ++n)
#pragma unroll
        for (int j = 0; j < 4; ++j) {
          float g = acc[m][n][j], u = acc[m][n + 2][j];
          S[(m * 16 + fq * 4 + j) * 40 + n * 16 + fr] = f2bf_hw(silu_f(g) * u);
        }
    bf16_t* gp = hid + (size_t)wrow0 * 2816 + (col0 >> 1) + wc * 32;
#pragma unroll
    for (int it = 0; it < MT; ++it) {
      const int r = it * 16 + (lane >> 2), c = (lane & 3) * 8;
      *(uint4*)(gp + (size_t)r * 2816 + c) = *(const uint4*)(S + r * 40 + c);
    }
  } else if constexpr (EPI == EPI_F32) {
    static_assert(EPI != EPI_F32 || MT == 4, "f32 epilogue staged for 64-row wave tiles");
    float* o = (float*)ea.o0;
    float* S = (float*)(smem + wv * 17408);
#pragma unroll
    for (int m = 0; m < MT; ++m)
#pragma unroll
      for (int n = 0; n < 4; ++n)
#pragma unroll
        for (int j = 0; j < 4; ++j) S[(m * 16 + fq * 4 + j) * 68 + n * 16 + fr] = acc[m][n][j];
    float* gp = o + (size_t)wrow0 * 1024 + wcol0;
#pragma unroll
    for (int it = 0; it < 16; ++it) {
      const int r = it * 4 + (lane >> 4), c = (lane & 15) * 4;
      *(float4*)(gp + (size_t)r * 1024 + c) = *(const float4*)(S + r * 68 + c);
    }
  } else if constexpr (EPI == EPI_PART) {
    bf16_t* o = (bf16_t*)ea.o0;
    bf16_t* S = (bf16_t*)(smem + 65536 + wv * 9216);
#pragma unroll
    for (int mh = 0; mh < MT / 4; ++mh) {
#pragma unroll
      for (int m = 0; m < 4; ++m)
#pragma unroll
        for (int n = 0; n < 4; ++n)
#pragma unroll
          for (int j = 0; j < 4; ++j) S[(m * 16 + fq * 4 + j) * 72 + n * 16 + fr] = f2bf_hw(acc[mh * 4 + m][n][j]);
      flush64_bf16(S, o + (size_t)(wrow0 + mh * 64) * 1024 + wcol0, 1024, lane);
    }
  } else if constexpr (EPI == EPI_GELU_U) {
    bf16_t* o = (bf16_t*)ea.o0;
    bf16_t* S = (bf16_t*)(smem + 65536 + wv * 9216);
#pragma unroll
    for (int mh = 0; mh < MT / 4; ++mh) {
#pragma unroll
      for (int m = 0; m < 4; ++m)
#pragma unroll
        for (int n = 0; n < 4; ++n)
#pragma unroll
          for (int j = 0; j < 4; ++j) S[(m * 16 + fq * 4 + j) * 72 + n * 16 + fr] = f2bf(gelu_f(acc[mh * 4 + m][n][j]));
      flush64_bf16(S, o + (size_t)(wrow0 + mh * 64) * 3072 + wcol0, 3072, lane);
    }
  } else if constexpr (EPI == EPI_GELU_VT) {
    bf16_t* o = (bf16_t*)ea.o0;
    float* stats = (float*)ea.o1;
    bf16_t* S = (bf16_t*)(smem + 65536 + wv * 9216);
    float s1[4] = {0.f, 0.f, 0.f, 0.f}, s2[4] = {0.f, 0.f, 0.f, 0.f};
#pragma unroll
    for (int mh = 0; mh < MT / 4; ++mh) {
#pragma unroll
      for (int m = 0; m < 4; ++m)
#pragma unroll
        for (int n = 0; n < 4; ++n)
#pragma unroll
          for (int j = 0; j < 4; ++j) {
            float g = gelu_f(acc[mh * 4 + m][n][j]);
            S[(m * 16 + fq * 4 + j) * 72 + n * 16 + fr] = f2bf(g);
            s1[n] += g; s2[n] += g * g;
          }
      flush64_bf16(S, o + (size_t)(wrow0 + mh * 64) * 8192 + wcol0, 8192, lane);
    }
#pragma unroll
    for (int n = 0; n < 4; ++n) {
      float a1 = s1[n], a2 = s2[n];
      a1 += __shfl_xor(a1, 16); a2 += __shfl_xor(a2, 16);
      a1 += __shfl_xor(a1, 32); a2 += __shfl_xor(a2, 32);
      if (fq == 0) ((float2*)stats)[(size_t)(row0 / (MT * 16) + wr) * 8192 + cb + n * 16] = make_float2(a1, a2);
    }
  } else if constexpr (EPI == EPI_SPATIAL) {
    bf16_t* o = (bf16_t*)ea.o0;
    const bf16_t* u = (const bf16_t*)ea.a0;
    const float* bs = (const float*)ea.a1 + ea.i0 * 128;
    bf16_t* S = (bf16_t*)(smem + 65536 + wv * 9216);
    const bf16_t* up = u + (size_t)wrow0 * 3072 + wcol0;
#pragma unroll
    for (int it = 0; it < 8; ++it) {
      const int r = it * 8 + (lane >> 3), c = (lane & 7) * 8;
      *(uint4*)(S + r * 72 + c) = *(const uint4*)(up + (size_t)r * 3072 + c);
    }
#pragma unroll
    for (int m = 0; m < MT; ++m)
#pragma unroll
      for (int j = 0; j < 4; ++j) {
        const int rl = m * 16 + fq * 4 + j;
        const float bias = bs[(wrow0 + rl) & 127];
#pragma unroll
        for (int n = 0; n < 4; ++n) {
          bf16_t* sp = S + rl * 72 + n * 16 + fr;
          *sp = f2bf((acc[m][n][j] + bias) * bf2f(*sp));
        }
      }
    flush64_bf16(S, o + (size_t)wrow0 * 3072 + wcol0, 3072, lane);
  } else if constexpr (EPI == EPI_QKV) {
    static_assert(EPI != EPI_QKV || MT == 4, "qkv epilogue staged for 64-row wave tiles");
    bf16_t* o = (bf16_t*)ea.o0;
    bf16_t* S = (bf16_t*)(smem + 65536 + wv * 9216);
    const int slot = (col0 + wc * 64) >> 6;
    const float inv = __expf(-(float)fr * (9.210340371976184f / 16.f));
#pragma unroll
    for (int m = 0; m < MT; ++m)
#pragma unroll
      for (int j = 0; j < 4; ++j) {
        int r = rb + m * 16 + j;
        float v0 = acc[m][0][j], v1 = acc[m][1][j], v2 = acc[m][2][j], v3 = acc[m][3][j];
        if (r >= 4096) {
          if (slot < 20) {
            int t = (r - 4096) & 1023;
            float sr, cr, sc_, cc_;
            __sincosf((float)(t >> 6) * inv, &sr, &cr);
            __sincosf((float)(t & 63) * inv, &sc_, &cc_);
            float n0 = v0 * cr - v1 * sr, n1 = v1 * cr + v0 * sr;
            float n2 = v2 * cc_ - v3 * sc_, n3 = v3 * cc_ + v2 * sc_;
            v0 = n0; v1 = n1; v2 = n2; v3 = n3;
          }
        } else if (slot >= 16) {
          float* oc = p.out + 8388608 + (slot >= 20 ? 1048576 : 0) + ((size_t)r * 4 + ((slot - 16) & 3)) * 64 + fr;
          oc[0] = v0; oc[16] = v1; oc[32] = v2; oc[48] = v3;
        }
        bf16_t* sp = S + (m * 16 + fq * 4 + j) * 72 + fr;
        sp[0] = f2bf_hw(v0); sp[16] = f2bf_hw(v1); sp[32] = f2bf_hw(v2); sp[48] = f2bf_hw(v3);
      }
    flush64_bf16(S, o + (size_t)wrow0 * 1536 + wcol0, 1536, lane);
  } else if constexpr (EPI == EPI_SSMIN) {
    bf16_t* o = (bf16_t*)ea.o0;
    float* dtb = (float*)ea.o1;
    if (wcol0 < 5120) {
      bf16_t* S = (bf16_t*)(smem + 65536 + wv * 9216);
#pragma unroll
      for (int mh = 0; mh < MT / 4; ++mh) {
#pragma unroll
        for (int m = 0; m < 4; ++m)
#pragma unroll
          for (int n = 0; n < 4; ++n)
#pragma unroll
            for (int j = 0; j < 4; ++j) S[(m * 16 + fq * 4 + j) * 72 + n * 16 + fr] = f2bf(acc[mh * 4 + m][n][j]);
        flush64_bf16(S, o + (size_t)(wrow0 + mh * 64) * 5120 + wcol0, 5120, lane);
      }
    } else if (wcol0 == 5120) {
#pragma unroll
      for (int n = 0; n < 4; ++n) {
        int hh = n * 16 + fr;
        float bias = p.ssm_dt_bias[hh];
#pragma unroll
        for (int m = 0; m < MT; ++m)
#pragma unroll
          for (int j = 0; j < 4; ++j) {
            float xv = acc[m][n][j] + bias;
            float ev = __expf(xv);
            float sp = xv > 20.f ? xv : (ev < 0.01f ? ev * (1.f - ev * (0.5f - ev * 0.33333333f)) : __logf(1.f + ev));
            dtb[(size_t)(rb + m * 16 + j) * 64 + hh] = sp;
          }
      }
    }
  }
}

template <int EPI, int WM, int WN, int MT>
__device__ void gemm_phase(const Params& p, const bf16_t* A, int lda, const bf16_t* Bt, int ldb, int K, int tm, int tn,
                           char* smem, EA ea, const int wvs) {
  constexpr int BMt = WM * MT * 16, BNt = WN * 64;
  const int nt = tm * tn;
  const int tid = opaque_tid(wvs);
  constexpr bool OVL = (EPI == EPI_SWIGLU);
  int t = blockIdx.x;
  if constexpr (OVL) {
    if (t < nt) {
      __syncthreads();
      gemm_issue01<WM, WN, MT>(A + (size_t)(t % tm) * BMt * lda, lda, Bt + (size_t)(t / tm) * BNt * ldb, ldb, smem, tid);
    }
  }
  for (; t < nt; t += gridDim.x) {
    const int tr = t % tm, tc = t / tm;
    f32x4 acc[MT][4];
    gemm_pipe<WM, WN, MT, OVL>(A + (size_t)tr * BMt * lda, lda, Bt + (size_t)tc * BNt * ldb, ldb, K, smem, acc, tid);
    if constexpr (OVL) {
      const int t2 = t + gridDim.x;
      if (t2 < nt)
        gemm_issue01<WM, WN, MT>(A + (size_t)(t2 % tm) * BMt * lda, lda, Bt + (size_t)(t2 / tm) * BNt * ldb, ldb, smem, tid);
    }
    gemm_epi<EPI, WN, MT>(p, acc, tr * BMt, tc * BNt, ea, tid, smem, tid >> 6);
  }
}

template <int K>
__device__ __forceinline__ void gemm_splitk_body(const Params& p, const bf16_t* A, const bf16_t* Bt, char* smem, const int tid) {
  constexpr int Kh = K / 2;
  EA ea; ea.o1 = nullptr; ea.a0 = ea.a1 = nullptr; ea.i0 = ea.i1 = ea.i2 = ea.i3 = 0;
  for (int t = blockIdx.x; t < 256; t += gridDim.x) {
    const int tr = t & 31, tc = (t >> 5) & 3, kh = t >> 7;
    f32x4 acc[8][4];
    gemm_pipe<2, 4, 8>(A + (size_t)tr * 256 * K + kh * Kh, K, Bt + (size_t)tc * 256 * K + kh * Kh, K, Kh, smem, acc, tid);
    ea.o0 = (bf16_t*)p.f + (size_t)kh * 8192 * 1024;
    gemm_epi<EPI_PART, 4, 8>(p, acc, tr * 256, tc * 256, ea, tid, smem, tid >> 6);
  }
}
__device__ void gemm_splitk_phase(const Params& p, const bf16_t* A, const bf16_t* Bt, int K, char* smem, const int wvs) {
  const int tid = opaque_tid(wvs);
  if (K == 2816) gemm_splitk_body<2816>(p, A, Bt, smem, tid);
  else if (K == 3072) gemm_splitk_body<3072>(p, A, Bt, smem, tid);
  else if (K == 2048) gemm_splitk_body<2048>(p, A, Bt, smem, tid);
  else gemm_splitk_body<1024>(p, A, Bt, smem, tid);
}

__device__ void rowop_phase(const Params& p, bool first, bool has_f, int gl, int gslot, float coef, const float* gf,
                            bool has_next, int nl, const float* gn, int shslot, int scslot, const int wvs) {
  const int tid = opaque_tid(wvs); const int lane = tid & 63, wid = tid >> 6;
  for (int row = blockIdx.x * 8 + wid; row < 8192; row += gridDim.x * 8) {
    const int ci = row < 4096 ? 0 : 1 + ((row - 4096) >> 10);
    const float* xin = first ? (row < 4096 ? p.x_prompt + (size_t)row * 1024 : p.x_sample + (size_t)(row - 4096) * 1024)
                             : p.x + (size_t)row * 1024;
    float4 xv[4];
#pragma unroll
    for (int i = 0; i < 4; ++i) xv[i] = *(const float4*)(xin + i * 256 + lane * 4);
    if (has_f) {
      float4 fv[4];
      float ss = 0.f;
      const bf16_t* f0 = (const bf16_t*)p.f + (size_t)row * 1024;
      const bf16_t* f1 = f0 + (size_t)8192 * 1024;
#pragma unroll
      for (int i = 0; i < 4; ++i) {
        const uint2 q0 = *(const uint2*)(f0 + i * 256 + lane * 4), q1 = *(const uint2*)(f1 + i * 256 + lane * 4);
        fv[i] = make_float4(lo_f(q0.x) + lo_f(q1.x), hi_f(q0.x) + hi_f(q1.x), lo_f(q0.y) + lo_f(q1.y), hi_f(q0.y) + hi_f(q1.y));
        ss += fv[i].x * fv[i].x + fv[i].y * fv[i].y + fv[i].z * fv[i].z + fv[i].w * fv[i].w;
      }
#pragma unroll
      for (int o = 32; o > 0; o >>= 1) ss += __shfl_xor(ss, o);
      float rstd = rsqrtf(ss * (1.f / 1024.f) + 1e-6f) * coef;
      const float* gate = p.mod + ((size_t)(gl * 5 + ci) * 9 + gslot) * 1024;
#pragma unroll
      for (int i = 0; i < 4; ++i) {
        float4 g = *(const float4*)(gate + i * 256 + lane * 4);
        float4 w = *(const float4*)(gf + i * 256 + lane * 4);
        xv[i].x += g.x * fv[i].x * rstd * w.x; xv[i].y += g.y * fv[i].y * rstd * w.y;
        xv[i].z += g.z * fv[i].z * rstd * w.z; xv[i].w += g.w * fv[i].w * rstd * w.w;
      }
    }
    if (!has_next) {
#pragma unroll
      for (int i = 0; i < 4; ++i) *(float4*)(p.out + (size_t)row * 1024 + i * 256 + lane * 4) = xv[i];
    } else {
      float ss = 0.f;
#pragma unroll
      for (int i = 0; i < 4; ++i) {
        *(float4*)(p.x + (size_t)row * 1024 + i * 256 + lane * 4) = xv[i];
        ss += xv[i].x * xv[i].x + xv[i].y * xv[i].y + xv[i].z * xv[i].z + xv[i].w * xv[i].w;
      }
#pragma unroll
      for (int o = 32; o > 0; o >>= 1) ss += __shfl_xor(ss, o);
      float rstd = rsqrtf(ss * (1.f / 1024.f) + 1e-6f);
      const float* sh = p.mod + ((size_t)(nl * 5 + ci) * 9 + shslot) * 1024;
      const float* scl = p.mod + ((size_t)(nl * 5 + ci) * 9 + scslot) * 1024;
#pragma unroll
      for (int i = 0; i < 4; ++i) {
        float4 g = *(const float4*)(gn + i * 256 + lane * 4);
        float4 s = *(const float4*)(sh + i * 256 + lane * 4);
        float4 c = *(const float4*)(scl + i * 256 + lane * 4);
        float h0 = xv[i].x * rstd * g.x * (1.f + c.x) + s.x, h1 = xv[i].y * rstd * g.y * (1.f + c.y) + s.y;
        float h2 = xv[i].z * rstd * g.z * (1.f + c.z) + s.z, h3 = xv[i].w * rstd * g.w * (1.f + c.w) + s.w;
        *(uint2*)(p.h + (size_t)row * 1024 + i * 256 + lane * 4) = make_uint2(cvt_pk_bf16(h0, h1), cvt_pk_bf16(h2, h3));
      }
    }
  }
}

__device__ void gmlp_ln_phase(const Params& p, int jl, char* smem, const int wvs) {
  float* sMu = (float*)smem;
  float* sRs = sMu + 32;
  bf16_t* vT = (bf16_t*)(p.R + R_VT_OFF);
  const float2* part = (const float2*)p.stats + (size_t)jl * 48 * 8192;
  const float* lg = p.gmlp_ln_g + jl * 3072;
  const float* lb = p.gmlp_ln_b + jl * 3072;
  const int tid = opaque_tid(wvs);
  for (int u = blockIdx.x; u < 256; u += gridDim.x) {
    const int t0 = u * 32;
    __syncthreads();
    if (tid < 32) {
      float s1 = 0.f, s2 = 0.f;
      for (int k = 0; k < 24; ++k) { float2 v = part[(size_t)k * 8192 + t0 + tid]; s1 += v.x; s2 += v.y; }
      float mu = s1 * (1.f / 3072.f);
      sMu[tid] = mu;
      sRs[tid] = rsqrtf(fmaxf(s2 * (1.f / 3072.f) - mu * mu, 0.f) + 1e-6f);
    }
    __syncthreads();
    const int tq = tid & 3, nr = tid >> 2;
    float mu[8], rs[8];
#pragma unroll
    for (int e = 0; e < 8; ++e) { mu[e] = sMu[tq * 8 + e]; rs[e] = sRs[tq * 8 + e]; }
#pragma unroll 4
    for (int it = 0; it < 24; ++it) {
      const int n = it * 128 + nr;
      bf16_t* ptr = vT + (size_t)n * 8192 + t0 + tq * 8;
      uint4 v = *(uint4*)ptr;
      const float g = lg[n], b = lb[n];
      unsigned w[4] = {v.x, v.y, v.z, v.w};
      unsigned o[4];
#pragma unroll
      for (int e = 0; e < 4; ++e)
        o[e] = pack2((lo_f(w[e]) - mu[2 * e]) * rs[2 * e] * g + b, (hi_f(w[e]) - mu[2 * e + 1]) * rs[2 * e + 1] * g + b);
      *(uint4*)ptr = make_uint4(o[0], o[1], o[2], o[3]);
    }
  }
}

__device__ void gmlp_spatial_phase(const Params& p, int jl, char* smem, const int wvs) {
  const bf16_t* vT = (const bf16_t*)(p.R + R_VT_OFF);
  const bf16_t* ug = (const bf16_t*)(p.R + R_U_OFF);
  bf16_t* og = (bf16_t*)(p.R + R_GATED_OFF);
  const float2* part = (const float2*)p.stats + (size_t)jl * 48 * 8192;
  const float* lg = p.gmlp_ln_g + jl * 3072;
  const float* lb = p.gmlp_ln_b + jl * 3072;
  const int tid = opaque_tid(wvs), half = tid >> 8, tl = tid & 255;
  const int lane = tl & 63, wid = tl >> 6, wr = wid >> 1, wc = wid & 1, fr = lane & 15, fq = lane >> 4;
  char* hsm = smem + half * 65536;
  float* sMu = (float*)(smem + 139264 + half * 4096);
  float* sRs = sMu + 128;
  float* sS1 = sRs + 128;
  float* sS2 = sS1 + 128;
  const int swz = (fr >> 1) & 7;
  const int aoff = (wr * 64 + fr) * 128, boff = 16384 + (wc * 64 + fr) * 128;
  const int c0 = ((fq) ^ swz) * 16, c1 = ((4 + fq) ^ swz) * 16;
  for (int t0 = blockIdx.x * 2; t0 < 1536; t0 += gridDim.x * 2) {
    const int t = t0 + half;
    const int c = t & 63, r = t >> 6, g = r / 3, nt = r - g * 3;
    const bf16_t* A = p.ws_bf + ((size_t)jl * 8 + g) * 128 * 128;
    const bf16_t* B = vT + (size_t)(g * 384 + nt * 128) * 8192 + c * 128;
    __syncthreads();
    {
      const int r0 = tl >> 3, pos = tl & 7;
      const int cg = (pos ^ ((r0 >> 1) & 7)) * 8;
      const bf16_t* bp = B + (size_t)r0 * 8192 + cg;
#pragma unroll
      for (int kt = 0; kt < 2; ++kt)
#pragma unroll
        for (int i = 0; i < 4; ++i)
          __builtin_amdgcn_global_load_lds((const unsigned*)(bp + (size_t)(32 * i) * 8192 + kt * 64),
                                           (__attribute__((address_space(3))) unsigned*)(hsm + kt * 32768 + 16384 + tl * 16 + i * 4096), 16, 0, 0);
    }
    if (tl < 128) {
      float s1 = 0.f, s2 = 0.f;
      for (int k = 0; k < 24; ++k) { float2 v = part[(size_t)k * 8192 + c * 128 + tl]; s1 += v.x; s2 += v.y; }
      const float mu = s1 * (1.f / 3072.f);
      sMu[tl] = mu;
      sRs[tl] = rsqrtf(fmaxf(s2 * (1.f / 3072.f) - mu * mu, 0.f) + 1e-6f);
    }
    __syncthreads();
#pragma unroll
    for (int i = 0; i < 8; ++i) {
      const int row = (tl >> 4) + 16 * i, kc = tl & 15;
      const uint4 wv = *(const uint4*)(A + row * 128 + kc * 8);
      const unsigned w[4] = {wv.x, wv.y, wv.z, wv.w};
      unsigned o[4];
      float a1 = 0.f, a2 = 0.f;
#pragma unroll
      for (int e = 0; e < 4; ++e) {
        const int j = kc * 8 + 2 * e;
        const float w0 = lo_f(w[e]), w1 = hi_f(w[e]);
        const float q0 = w0 * sRs[j], q1 = w1 * sRs[j + 1];
        o[e] = pack2(q0, q1);
        a1 += q0 * sMu[j] + q1 * sMu[j + 1];
        a2 += w0 + w1;
      }
      *(uint4*)(hsm + (kc >> 3) * 32768 + row * 128 + (((kc & 7) ^ ((row >> 1) & 7)) * 16)) = make_uint4(o[0], o[1], o[2], o[3]);
#pragma unroll
      for (int m = 1; m < 16; m <<= 1) { a1 += __shfl_xor(a1, m); a2 += __shfl_xor(a2, m); }
      if (kc == 0) { sS1[row] = a1; sS2[row] = a2; }
    }
    asm volatile("s_waitcnt vmcnt(0)" ::: "memory");
    __syncthreads();
    f32x4 acc[4][4];
#pragma unroll
    for (int m = 0; m < 4; ++m)
#pragma unroll
      for (int n = 0; n < 4; ++n) acc[m][n] = f32x4{0.f, 0.f, 0.f, 0.f};
#pragma unroll
    for (int kt = 0; kt < 2; ++kt) {
      const char* S = hsm + kt * 32768;
#pragma unroll
      for (int kk = 0; kk < 2; ++kk) {
        const int cc = kk ? c1 : c0;
        bf16x8 a[4], bb[4];
#pragma unroll
        for (int m = 0; m < 4; ++m) a[m] = *(const bf16x8*)(S + aoff + m * 2048 + cc);
#pragma unroll
        for (int n = 0; n < 4; ++n) bb[n] = *(const bf16x8*)(S + boff + n * 2048 + cc);
#pragma unroll
        for (int m = 0; m < 4; ++m)
#pragma unroll
          for (int n = 0; n < 4; ++n) acc[m][n] = __builtin_amdgcn_mfma_f32_16x16x32_bf16(a[m], bb[n], acc[m][n], 0, 0, 0);
      }
    }
    __syncthreads();
    {
      const int wv = tid >> 6;
      bf16_t* S = (bf16_t*)(smem + 65536 + wv * 9216);
      const int wrow0 = c * 128 + wr * 64, wcol0 = g * 384 + nt * 128 + wc * 64;
      const bf16_t* up = ug + (size_t)wrow0 * 3072 + wcol0;
#pragma unroll
      for (int it = 0; it < 8; ++it) {
        const int rr = it * 8 + (lane >> 3), cc = (lane & 7) * 8;
        *(uint4*)(S + rr * 72 + cc) = *(const uint4*)(up + (size_t)rr * 3072 + cc);
      }
      const float* bs = p.gmlp_bs + jl * 1024 + g * 128;
      float lgn[4], lbn[4];
#pragma unroll
      for (int n = 0; n < 4; ++n) { lgn[n] = lg[wcol0 + n * 16 + fr]; lbn[n] = lb[wcol0 + n * 16 + fr]; }
#pragma unroll
      for (int m = 0; m < 4; ++m)
#pragma unroll
        for (int j = 0; j < 4; ++j) {
          const int rl = m * 16 + fq * 4 + j, i = wr * 64 + rl;
          const float s1 = sS1[i], s2 = sS2[i], bias = bs[i];
#pragma unroll
          for (int n = 0; n < 4; ++n) {
            bf16_t* sp = S + rl * 72 + n * 16 + fr;
            const float val = lgn[n] * (acc[m][n][j] - s1) + lbn[n] * s2 + bias;
            *sp = f2bf(val * bf2f(*sp));
          }
        }
      flush64_bf16(S, og + (size_t)wrow0 * 3072 + wcol0, 3072, lane);
    }
  }
}

__device__ void gmlp_in_phase(const Params& p, int jl, char* smem, const int wvs) {
  const bf16_t* W = p.wt_gmlp_in + (size_t)jl * 6144 * 1024;
  EA ea; ea.a0 = ea.a1 = nullptr; ea.i0 = ea.i1 = ea.i2 = ea.i3 = 0;
  const int tid = opaque_tid(wvs);
  for (int t = blockIdx.x; t < 384; t += gridDim.x) {
    f32x4 acc[8][4];
    int tr = t & 31, tc = t >> 5;
    gemm_pipe<2, 4, 8>(p.h + (size_t)tr * 256 * 1024, 1024, W + (size_t)tc * 256 * 1024, 1024, 1024, smem, acc, tid);
    ea.o0 = p.R + R_U_OFF; ea.o1 = nullptr;
    gemm_epi<EPI_GELU_U, 4, 8>(p, acc, tr * 256, tc * 256, ea, tid, smem, tid >> 6);
  }
  const int tid2 = opaque_tid(wvs);
  for (int t2 = (blockIdx.x + (gridDim.x >> 1)) % gridDim.x; t2 < 384; t2 += gridDim.x) {
    f32x4 acc[8][4];
    int tc = t2 & 31, tr = t2 >> 5;
    gemm_pipe<2, 4, 8>(W + (size_t)(3072 + tr * 256) * 1024, 1024, p.h + (size_t)tc * 256 * 1024, 1024, 1024, smem, acc, tid2);
    ea.o0 = p.R + R_VT_OFF; ea.o1 = p.stats + (size_t)jl * 48 * 8192 * 2;
    gemm_epi<EPI_GELU_VT, 4, 8>(p, acc, tr * 256, tc * 256, ea, tid2, smem, tid2 >> 6);
  }
}

__device__ __forceinline__ bf16x8 pack8(const f32x16& v, int s) {
  union { uint4 u; bf16x8 b; } x;
  x.u = make_uint4(cvt_pk_bf16(v[8 * s], v[8 * s + 1]), cvt_pk_bf16(v[8 * s + 2], v[8 * s + 3]),
                   cvt_pk_bf16(v[8 * s + 4], v[8 * s + 5]), cvt_pk_bf16(v[8 * s + 6], v[8 * s + 7]));
  return x.b;
}
__device__ __forceinline__ bf16x8 comb(uint2 lo, uint2 hi) {
  union { uint4 u; bf16x8 b; } x;
  x.u = make_uint4(lo.x, lo.y, hi.x, hi.y);
  return x.b;
}

__device__ void attn_phase(const Params& p, char* smem, const int wvs) {
  const int tid0 = opaque_tid(wvs), half = tid0 >> 8, tid = tid0 & 255;
  bf16_t* sK = (bf16_t*)(smem + half * HALF_SMEM);
  bf16_t* sVT = sK + 64 * 72;
  const bf16_t* qkv = (const bf16_t*)(p.R + R_QKV_OFF);
  bf16_t* ao = (bf16_t*)(p.R + R_AO_OFF);
  const int lane = tid & 63, wid = tid >> 6, l31 = lane & 31, hh = lane >> 5;
  for (int u = blockIdx.x * 2 + half; u < 1024; u += gridDim.x * 2) {
    const bool lat = u < 512;
    int b, hq, qb, rowbase;
    if (lat) { b = u >> 7; hq = (u >> 3) & 15; qb = u & 7; rowbase = 4096 + b * 1024; }
    else { int v = u - 512; b = v >> 5; hq = (v >> 1) & 15; qb = v & 1; rowbase = b * 256; }
    const int kvh = hq >> 2;
    const int qloc = qb * 128 + wid * 32 + l31;
    bf16x8 qf[4];
    {
      const bf16_t* qp = qkv + (size_t)(rowbase + qloc) * 1536 + hq * 64 + hh * 8;
#pragma unroll
      for (int s = 0; s < 4; ++s) qf[s] = *(const bf16x8*)(qp + 16 * s);
    }
    float m_run = p.attn_sink[hq] * 1.4426950408889634f, l_run = 1.f;
    f32x16 O[2];
#pragma unroll
    for (int r = 0; r < 16; ++r) { O[0][r] = 0.f; O[1][r] = 0.f; }
    const int ntiles = lat ? 10 : 4;
    for (int it = 0; it < ntiles; ++it) {
      int kpos0; bool fromcache = false, local = false, skip = false;
      if (lat) {
        if (it < 6) { kpos0 = qb * 128 - 128 + it * 64; local = true; skip = (kpos0 < 0 || kpos0 >= 1024); }
        else { fromcache = true; kpos0 = (it - 6) * 64; }
      } else kpos0 = it * 64;
      __syncthreads();
      if (!skip) {
        const int key = tid >> 2, ds = (tid & 3) * 16;
        unsigned kw[8], vw[8];
        if (fromcache) {
          const float* kp = p.cache_k + (((size_t)b * 256 + kpos0 + key) * 4 + kvh) * 64 + ds;
          const float* vp = p.cache_v + (((size_t)b * 256 + kpos0 + key) * 4 + kvh) * 64 + ds;
#pragma unroll
          for (int e = 0; e < 4; ++e) {
            float4 a = *(const float4*)(kp + 4 * e), c = *(const float4*)(vp + 4 * e);
            kw[2 * e] = cvt_pk_bf16(a.x, a.y); kw[2 * e + 1] = cvt_pk_bf16(a.z, a.w);
            vw[2 * e] = cvt_pk_bf16(c.x, c.y); vw[2 * e + 1] = cvt_pk_bf16(c.z, c.w);
          }
        } else {
          const bf16_t* kp = qkv + (size_t)(rowbase + kpos0 + key) * 1536 + 1024 + kvh * 64 + ds;
          uint4 a0 = *(const uint4*)kp, a1 = *(const uint4*)(kp + 8);
          uint4 c0 = *(const uint4*)(kp + 256), c1 = *(const uint4*)(kp + 264);
          kw[0] = a0.x; kw[1] = a0.y; kw[2] = a0.z; kw[3] = a0.w; kw[4] = a1.x; kw[5] = a1.y; kw[6] = a1.z; kw[7] = a1.w;
          vw[0] = c0.x; vw[1] = c0.y; vw[2] = c0.z; vw[3] = c0.w; vw[4] = c1.x; vw[5] = c1.y; vw[6] = c1.z; vw[7] = c1.w;
        }
        *(uint4*)(sK + key * 72 + ds) = make_uint4(kw[0], kw[1], kw[2], kw[3]);
        *(uint4*)(sK + key * 72 + ds + 8) = make_uint4(kw[4], kw[5], kw[6], kw[7]);
#pragma unroll
        for (int e = 0; e < 8; ++e) {
          sVT[(ds + 2 * e) * 72 + key] = (bf16_t)(vw[e] & 0xffffu);
          sVT[(ds + 2 * e + 1) * 72 + key] = (bf16_t)(vw[e] >> 16);
        }
      }
      __syncthreads();
      if (!skip) {
      f32x16 st[2];
#pragma unroll
      for (int t = 0; t < 2; ++t) {
        f32x16 a;
#pragma unroll
        for (int r = 0; r < 16; ++r) a[r] = 0.f;
#pragma unroll
        for (int s = 0; s < 4; ++s) {
          bf16x8 kf = *(const bf16x8*)(sK + (32 * t + l31) * 72 + 16 * s + 8 * hh);
          a = __builtin_amdgcn_mfma_f32_32x32x16_bf16(kf, qf[s], a, 0, 0, 0);
        }
        st[t] = a;
      }
      float mx = -1e30f;
#pragma unroll
      for (int t = 0; t < 2; ++t)
#pragma unroll
        for (int r = 0; r < 16; ++r) {
          float s = st[t][r] * (0.125f * 1.4426950408889634f);
          if (local) {
            int key = kpos0 + 32 * t + (r & 3) + 8 * (r >> 2) + 4 * hh;
            int d = qloc - key;
            if (d > 128 || d < -128) s = -1e30f;
          }
          st[t][r] = s;
          mx = fmaxf(mx, s);
        }
      mx = fmaxf(mx, __shfl_xor(mx, 32));
      float mn = fmaxf(m_run, mx);
      float alpha = __builtin_amdgcn_exp2f(m_run - mn);
      float ps = 0.f;
#pragma unroll
      for (int t = 0; t < 2; ++t)
#pragma unroll
        for (int r = 0; r < 16; ++r) { float pv = __builtin_amdgcn_exp2f(st[t][r] - mn); st[t][r] = pv; ps += pv; }
      ps += __shfl_xor(ps, 32);
      l_run = l_run * alpha + ps; m_run = mn;
#pragma unroll
      for (int r = 0; r < 16; ++r) { O[0][r] *= alpha; O[1][r] *= alpha; }
#pragma unroll
      for (int t = 0; t < 2; ++t)
#pragma unroll
        for (int s2 = 0; s2 < 2; ++s2) {
          bf16x8 pf = pack8(st[t], s2);
#pragma unroll
          for (int dt = 0; dt < 2; ++dt) {
            const bf16_t* vp = sVT + (32 * dt + l31) * 72 + 32 * t + 16 * s2 + 4 * hh;
            bf16x8 vf = comb(*(const uint2*)vp, *(const uint2*)(vp + 8));
            O[dt] = __builtin_amdgcn_mfma_f32_32x32x16_bf16(vf, pf, O[dt], 0, 0, 0);
          }
        }
      }
    }
    const float inv = 1.f / l_run;
    bf16_t* op = ao + (size_t)(rowbase + qloc) * 1024 + hq * 64 + 4 * hh;
#pragma unroll
    for (int dt = 0; dt < 2; ++dt)
#pragma unroll
      for (int k = 0; k < 4; ++k)
        *(uint2*)(op + 32 * dt + 8 * k) = make_uint2(cvt_pk_bf16(O[dt][4 * k] * inv, O[dt][4 * k + 1] * inv),
                                                     cvt_pk_bf16(O[dt][4 * k + 2] * inv, O[dt][4 * k + 3] * inv));
  }
}

__device__ void conv_phase(const Params& p, const int wvs) {
  const bf16_t* zx = (const bf16_t*)(p.R + R_ZX_OFF);
  bf16_t* xc = (bf16_t*)(p.R + R_XC_OFF);
  const int tid = opaque_tid(wvs);
  for (int base = blockIdx.x * NTHR; base < 8192 * 384; base += gridDim.x * NTHR) {
    const int i = base + tid;
    int row = i / 384, cg8 = (i - row * 384) * 8;
    int s, T;
    if (row < 4096) { s = row & 255; T = 256; } else { s = (row - 4096) & 1023; T = 1024; }
    const bf16_t* src = zx + (size_t)row * 5120 + 2048 + cg8;
    uint4 c = *(const uint4*)src, a = make_uint4(0, 0, 0, 0), n = make_uint4(0, 0, 0, 0);
    if (s > 0) a = *(const uint4*)(src - 5120);
    if (s < T - 1) n = *(const uint4*)(src + 5120);
    unsigned aw[4] = {a.x, a.y, a.z, a.w}, cw[4] = {c.x, c.y, c.z, c.w}, nw[4] = {n.x, n.y, n.z, n.w}, o[4];
#pragma unroll
    for (int e = 0; e < 4; ++e) {
      int ch = cg8 + 2 * e;
      float w00 = p.ssm_conv_w[ch], w01 = p.ssm_conv_w[3072 + ch], w02 = p.ssm_conv_w[6144 + ch], b0 = p.ssm_conv_b[ch];
      float w10 = p.ssm_conv_w[ch + 1], w11 = p.ssm_conv_w[3072 + ch + 1], w12 = p.ssm_conv_w[6144 + ch + 1], b1 = p.ssm_conv_b[ch + 1];
      float y0 = b0 + w00 * lo_f(aw[e]) + w01 * lo_f(cw[e]) + w02 * lo_f(nw[e]);
      float y1 = b1 + w10 * hi_f(aw[e]) + w11 * hi_f(cw[e]) + w12 * hi_f(nw[e]);
      o[e] = cvt_pk_bf16(silu_f(y0), silu_f(y1));
    }
    *(uint4*)(xc + (size_t)row * 3072 + cg8) = make_uint4(o[0], o[1], o[2], o[3]);
  }
}

__device__ void ssd_phase(const Params& p, char* smem, const int wvs) {
  const int tid0 = opaque_tid(wvs), half = tid0 >> 8, tid = tid0 & 255;
  bf16_t* sXT = (bf16_t*)(smem + half * HALF_SMEM);
  bf16_t* sBT = sXT + 64 * 136;
  bf16_t* sH = sBT + 128 * 136;
  float* sAc = (float*)(sH + 64 * 136);
  float* sDt = sAc + 128;
  const bf16_t* xc = (const bf16_t*)(p.R + R_XC_OFF);
  const float* dtb = (const float*)(p.R + R_DT_OFF);
  bf16_t* yb = (bf16_t*)(p.R + R_Y_OFF);
  const int lane = tid & 63, wid = tid >> 6, l31 = lane & 31, hh = lane >> 5;
  for (int w = blockIdx.x * 2 + half; w < 512; w += gridDim.x * 2)
  for (int sub = 0; sub < (w < 256 ? 1 : 4); ++sub) {
    const bool lat = w < 256;
    int b, dir, h, rowbase, T, nch;
    if (lat) { int u = w; b = u >> 6; dir = (u >> 5) & 1; h = u & 31; rowbase = 4096 + b * 1024; T = 1024; nch = 8; }
    else { int v = (w - 256) * 4 + sub; b = v >> 6; dir = (v >> 5) & 1; h = v & 31; rowbase = b * 256; T = 256; nch = 2; }
    const int g = h >> 3;
    const float a = -expf(p.ssm_a_log[dir * 32 + h]);
    const int ncol = 32 * wid + l31;
    f32x16 st[2];
    if (lat) {
      const float* h0 = p.state_ssm + (((size_t)b * 2 + dir) * 32 + h) * 64 * 128;
#pragma unroll
      for (int pt = 0; pt < 2; ++pt)
#pragma unroll
        for (int r = 0; r < 16; ++r) st[pt][r] = h0[(size_t)(32 * pt + (r & 3) + 8 * (r >> 2) + 4 * hh) * 128 + ncol];
    } else {
#pragma unroll
      for (int r = 0; r < 16; ++r) { st[0][r] = 0.f; st[1][r] = 0.f; }
    }
    for (int c = 0; c < nch; ++c) {
#define ROWOF(i) ((size_t)(rowbase + (dir ? (T - 1 - (c * 128 + (i))) : (c * 128 + (i)))))
      __syncthreads();
      const int myi = ncol;
      const size_t myrow = ROWOF(myi);
      bf16x8 cf[8];
#pragma unroll
      for (int s = 0; s < 8; ++s) cf[s] = *(const bf16x8*)(xc + myrow * 3072 + 2560 + g * 128 + 16 * s + 8 * hh);
      float dtv = 0.f;
      if (tid < 128) dtv = dtb[ROWOF(tid) * 64 + dir * 32 + h];
      uint4 xr[4], br[8];
      {
        const int i = tid >> 1;
        const uint4* srcx = (const uint4*)(xc + ROWOF(i) * 3072 + h * 64 + (tid & 1) * 32);
        const uint4* srcb = (const uint4*)(xc + ROWOF(i) * 3072 + 2048 + g * 128 + (tid & 1) * 64);
#pragma unroll
        for (int q = 0; q < 4; ++q) xr[q] = srcx[q];
#pragma unroll
        for (int q = 0; q < 8; ++q) br[q] = srcb[q];
      }
#pragma unroll
      for (int pt = 0; pt < 2; ++pt)
#pragma unroll
        for (int r = 0; r < 16; ++r) sH[(32 * pt + (r & 3) + 8 * (r >> 2) + 4 * hh) * 136 + ncol] = f2bf_hw(st[pt][r]);
      if (tid < 128) {
        float v = a * dtv;
#pragma unroll
        for (int o = 1; o < 64; o <<= 1) { float t = __shfl_up(v, o); if (lane >= o) v += t; }
        sAc[tid] = v; sDt[tid] = dtv;
      }
      {
        const int i = tid >> 1, ps = (tid & 1) * 32;
#pragma unroll
        for (int q = 0; q < 4; ++q) {
          unsigned w[4] = {xr[q].x, xr[q].y, xr[q].z, xr[q].w};
#pragma unroll
          for (int e = 0; e < 4; ++e) {
            sXT[(ps + q * 8 + 2 * e) * 136 + i] = (bf16_t)(w[e] & 0xffffu);
            sXT[(ps + q * 8 + 2 * e + 1) * 136 + i] = (bf16_t)(w[e] >> 16);
          }
        }
      }
      {
        const int j = tid >> 1, ns = (tid & 1) * 64;
#pragma unroll
        for (int q = 0; q < 8; ++q) *(uint4*)(sBT + j * 136 + ns + q * 8) = br[q];
      }
      __syncthreads();
      if (tid >= 64 && tid < 128) sAc[tid] += sAc[63];
      __syncthreads();
      const float alast = sAc[127];
      const float aci = sAc[myi];
      f32x16 Y[2];
#pragma unroll
      for (int r = 0; r < 16; ++r) { Y[0][r] = 0.f; Y[1][r] = 0.f; }
#pragma unroll
      for (int s = 0; s < 8; ++s)
#pragma unroll
        for (int pt = 0; pt < 2; ++pt) {
          bf16x8 hf = *(const bf16x8*)(sH + (32 * pt + l31) * 136 + 16 * s + 8 * hh);
          Y[pt] = __builtin_amdgcn_mfma_f32_32x32x16_bf16(hf, cf[s], Y[pt], 0, 0, 0);
        }
      {
        const float ei = __expf(aci);
#pragma unroll
        for (int r = 0; r < 16; ++r) { Y[0][r] *= ei; Y[1][r] *= ei; }
      }
      for (int jt = 0; jt <= wid; ++jt) {
        f32x16 G;
#pragma unroll
        for (int r = 0; r < 16; ++r) G[r] = 0.f;
#pragma unroll
        for (int s = 0; s < 8; ++s) {
          const bf16x8 bf = *(const bf16x8*)(sBT + (32 * jt + l31) * 136 + 16 * s + 8 * hh);
          G = __builtin_amdgcn_mfma_f32_32x32x16_bf16(bf, cf[s], G, 0, 0, 0);
        }
#pragma unroll
        for (int r = 0; r < 16; ++r) {
          int j = 32 * jt + (r & 3) + 8 * (r >> 2) + 4 * hh;
          float w = G[r] * __expf(fminf(aci - sAc[j], 0.f)) * sDt[j];
          G[r] = (j <= myi) ? w : 0.f;
        }
#pragma unroll
        for (int s2 = 0; s2 < 2; ++s2) {
          bf16x8 wf = pack8(G, s2);
#pragma unroll
          for (int pt = 0; pt < 2; ++pt) {
            const bf16_t* xp = sXT + (32 * pt + l31) * 136 + 32 * jt + 16 * s2 + 4 * hh;
            bf16x8 xf = comb(*(const uint2*)xp, *(const uint2*)(xp + 8));
            Y[pt] = __builtin_amdgcn_mfma_f32_32x32x16_bf16(xf, wf, Y[pt], 0, 0, 0);
          }
        }
      }
      {
        bf16_t* op = yb + ((size_t)dir * 8192 + myrow) * 2048 + h * 64 + 4 * hh;
#pragma unroll
        for (int pt = 0; pt < 2; ++pt)
#pragma unroll
          for (int k = 0; k < 4; ++k)
            *(uint2*)(op + 32 * pt + 8 * k) = make_uint2(cvt_pk_bf16(Y[pt][4 * k], Y[pt][4 * k + 1]), cvt_pk_bf16(Y[pt][4 * k + 2], Y[pt][4 * k + 3]));
      }
      __syncthreads();
      {
        const int j = tid >> 1, ns = (tid & 1) * 64;
        const float sc = sDt[j] * __expf(alast - sAc[j]);
#pragma unroll
        for (int q = 0; q < 8; ++q) {
          unsigned w[4] = {br[q].x, br[q].y, br[q].z, br[q].w};
#pragma unroll
          for (int e = 0; e < 4; ++e) {
            sBT[(ns + q * 8 + 2 * e) * 136 + j] = f2bf_hw(lo_f(w[e]) * sc);
            sBT[(ns + q * 8 + 2 * e + 1) * 136 + j] = f2bf_hw(hi_f(w[e]) * sc);
          }
        }
      }
      __syncthreads();
      {
        const float el = __expf(alast);
#pragma unroll
        for (int r = 0; r < 16; ++r) { st[0][r] *= el; st[1][r] *= el; }
      }
#pragma unroll
      for (int s = 0; s < 8; ++s) {
        bf16x8 bfr = *(const bf16x8*)(sBT + (32 * wid + l31) * 136 + 16 * s + 8 * hh);
#pragma unroll
        for (int pt = 0; pt < 2; ++pt) {
          bf16x8 xf = *(const bf16x8*)(sXT + (32 * pt + l31) * 136 + 16 * s + 8 * hh);
          st[pt] = __builtin_amdgcn_mfma_f32_32x32x16_bf16(xf, bfr, st[pt], 0, 0, 0);
        }
      }
#undef ROWOF
    }
    if (!lat) {
      float* so = p.out + 10485760 + (((size_t)b * 2 + dir) * 32 + h) * 64 * 128;
#pragma unroll
      for (int pt = 0; pt < 2; ++pt)
#pragma unroll
        for (int r = 0; r < 16; ++r) so[(size_t)(32 * pt + (r & 3) + 8 * (r >> 2) + 4 * hh) * 128 + ncol] = st[pt][r];
    }
  }
}

__device__ void ssm_post_phase(const Params& p, const int wvs) {
  const bf16_t* zx = (const bf16_t*)(p.R + R_ZX_OFF);
  const bf16_t* xc = (const bf16_t*)(p.R + R_XC_OFF);
  const bf16_t* yb = (const bf16_t*)(p.R + R_Y_OFF);
  bf16_t* yn = p.hid;
  const int tid = opaque_tid(wvs); const int lane = tid & 63, wid = tid >> 6;
  for (int row = blockIdx.x * 8 + wid; row < 8192; row += gridDim.x * 8) {
    float y[32];
    float ss = 0.f;
#pragma unroll
    for (int i = 0; i < 4; ++i) {
      int col = (i * 64 + lane) * 8;
      uint4 f = *(const uint4*)(yb + (size_t)row * 2048 + col);
      uint4 bk = *(const uint4*)(yb + ((size_t)8192 + row) * 2048 + col);
      uint4 xs = *(const uint4*)(xc + (size_t)row * 3072 + col);
      uint4 z = *(const uint4*)(zx + (size_t)row * 5120 + col);
      float d = p.ssm_d[col >> 6];
      unsigned fw[4] = {f.x, f.y, f.z, f.w}, bw[4] = {bk.x, bk.y, bk.z, bk.w}, xw[4] = {xs.x, xs.y, xs.z, xs.w}, zw[4] = {z.x, z.y, z.z, z.w};
#pragma unroll
      for (int e = 0; e < 4; ++e) {
        float v0 = (lo_f(fw[e]) + lo_f(bw[e]) + d * lo_f(xw[e])) * silu_f(lo_f(zw[e]));
        float v1 = (hi_f(fw[e]) + hi_f(bw[e]) + d * hi_f(xw[e])) * silu_f(hi_f(zw[e]));
        y[i * 8 + 2 * e] = v0; y[i * 8 + 2 * e + 1] = v1;
        ss += v0 * v0 + v1 * v1;
      }
    }
#pragma unroll
    for (int o = 32; o > 0; o >>= 1) ss += __shfl_xor(ss, o);
    float rstd = rsqrtf(ss * (1.f / 2048.f) + 1e-6f);
#pragma unroll
    for (int i = 0; i < 4; ++i) {
      int col = (i * 64 + lane) * 8;
      float4 g0 = *(const float4*)(p.ssm_norm + col), g1 = *(const float4*)(p.ssm_norm + col + 4);
      *(uint4*)(yn + (size_t)row * 2048 + col) =
          make_uint4(cvt_pk_bf16(y[i * 8] * rstd * g0.x, y[i * 8 + 1] * rstd * g0.y), cvt_pk_bf16(y[i * 8 + 2] * rstd * g0.z, y[i * 8 + 3] * rstd * g0.w),
                     cvt_pk_bf16(y[i * 8 + 4] * rstd * g1.x, y[i * 8 + 5] * rstd * g1.y), cvt_pk_bf16(y[i * 8 + 6] * rstd * g1.z, y[i * 8 + 7] * rstd * g1.w));
    }
  }
}


#define XB_TMO      128
#define XB_XCNT(j)  (256  + 64 * (j))
#define XB_XSUB(j)  (1280 + 64 * (j))
#define XB_XGEN(j)  (2304 + 64 * (j))
#define XB_TOP      3328
#define XB_TOPGEN   3392
#define XCD_BAR_WORDS 3456
#define XB_SPIN_CAP (1u << 18)
#define LAS __attribute__((address_space(3)))

__device__ __forceinline__ unsigned xb_ld(unsigned* p)              { return __hip_atomic_load(p, __ATOMIC_RELAXED, __HIP_MEMORY_SCOPE_AGENT); }
__device__ __forceinline__ unsigned xb_add(unsigned* p, unsigned v) { return __hip_atomic_fetch_add(p, v, __ATOMIC_RELAXED, __HIP_MEMORY_SCOPE_AGENT); }
__device__ __forceinline__ unsigned xb_xcc_id() { return (unsigned)__builtin_amdgcn_s_getreg((3 << 11) | 20) & 0xFu; }
#define XB_SPIN(cond, bar) do { unsigned _sp = 0; while (cond) { __builtin_amdgcn_s_sleep(1); \
    if ((++_sp & 255u) == 0u) { if (xb_ld(&(bar)[XB_TMO])) break; if (_sp > XB_SPIN_CAP) { atomicAdd(&(bar)[XB_TMO], 1u); break; } } } } while (0)

struct XcdBarrier { unsigned* bar; unsigned x; volatile LAS unsigned* st; };

__device__ __forceinline__ XcdBarrier xcd_barrier_post(unsigned* bar, volatile LAS unsigned* st) {
  XcdBarrier b; b.bar = bar; b.x = xb_xcc_id(); b.st = st;
  if (threadIdx.x == 0) (void)xb_add(&bar[XB_XCNT(b.x)], 1u);
  return b;
}
__device__ __forceinline__ void xcd_barrier_complete(unsigned* bar, unsigned x, unsigned& nloc, unsigned& nx) {
  const unsigned G = gridDim.x * gridDim.y * gridDim.z;
  unsigned sum, cnt, mine, sp = 0u;
  for (;;) {
    sum = 0u; cnt = 0u; mine = 0u;
#pragma unroll
    for (unsigned j = 0; j < 16; ++j) { const unsigned c = xb_ld(&bar[XB_XCNT(j)]); sum += c; cnt += (c > 0u) ? 1u : 0u; mine = (j == x) ? c : mine; }
    if (sum == G) break;
    __builtin_amdgcn_s_sleep(1);
    if ((++sp & 255u) == 0u) { if (xb_ld(&bar[XB_TMO])) break; if (sp > XB_SPIN_CAP) { atomicAdd(&bar[XB_TMO], 1u); break; } }
  }
  nloc = mine > 0u ? mine : 1u; nx = cnt > 0u ? cnt : 1u;
}
__device__ __forceinline__ void xcd_barrier(const XcdBarrier& b, const int wvs) {
  asm volatile("s_waitcnt vmcnt(0)" ::: "memory");
  __syncthreads();
  if (opaque_tid(wvs) == 0) {
    unsigned* bar = b.bar;
    __builtin_amdgcn_s_waitcnt(0);
    unsigned nloc = b.st[0], nx = b.st[1];
    if (nloc == 0u) { xcd_barrier_complete(bar, b.x, nloc, nx); b.st[0] = nloc; b.st[1] = nx; }
    const unsigned old = xb_add(&bar[XB_XSUB(b.x)], 1u);
    const unsigned gen = old / nloc;
    if (old + 1u == (gen + 1u) * nloc) {
      __builtin_amdgcn_fence(__ATOMIC_RELEASE, "agent");
      asm volatile("s_waitcnt vmcnt(0)" ::: "memory");
      const unsigned og = xb_add(&bar[XB_TOP], 1u);
      const unsigned tg = og / nx;
      if (og + 1u == (tg + 1u) * nx) xb_add(&bar[XB_TOPGEN], 1u);
      else XB_SPIN(xb_ld(&bar[XB_TOPGEN]) == tg, bar);
      __builtin_amdgcn_fence(__ATOMIC_ACQUIRE, "agent");
      xb_add(&bar[XB_XGEN(b.x)], 1u);
      asm volatile("s_waitcnt vmcnt(0)" ::: "memory");
    } else {
      XB_SPIN(xb_ld(&bar[XB_XGEN(b.x)]) == gen, bar);
      __builtin_amdgcn_fence(__ATOMIC_ACQUIRE, "agent");
      asm volatile("s_waitcnt vmcnt(0)" ::: "memory");
    }
  }
  __syncthreads();
}

enum { PH_PREP = 0, PH_ROW_A, PH_ROW_B, PH_ROW_C, PH_ROW_F, PH_SWIGLU, PH_FFNOUT, PH_GM_IN, PH_GM_SP, PH_GM_OUT, PH_GM_LN,
       PH_QKV, PH_ATT, PH_AT_OUT, PH_SS_IN, PH_CONV, PH_SSD, PH_POST, PH_SS_OUT };

__device__ __forceinline__ void decode_phase(int ph, int& type, int& l, int& half) {
  l = 0; half = 0;
  if (ph == 0) { type = PH_PREP; return; }
  if (ph >= 43) { type = PH_ROW_F; return; }
  int q = ph - 1;
  if (q >= 32) { l = 3; q -= 32; } else if (q >= 20) { l = 2; q -= 20; } else if (q >= 10) { l = 1; q -= 10; }
  const int kind = l % 3;
  const int nm = kind == 0 ? 3 : (kind == 1 ? 3 : 5);
  if (q == 0) { type = PH_ROW_A; return; }
  if (q == 1) { type = PH_SWIGLU; return; }
  if (q == 2) { type = PH_FFNOUT; return; }
  if (q == 3) { type = PH_ROW_B; return; }
  if (q < 4 + nm) {
    int m = q - 4;
    type = kind == 0 ? PH_GM_IN + m : (kind == 1 ? PH_QKV + m : PH_SS_IN + m);
    return;
  }
  q -= 4 + nm; half = 1;
  type = q == 0 ? PH_ROW_C : (q == 1 ? PH_SWIGLU : PH_FFNOUT);
}

__global__ void __launch_bounds__(NTHR, 2) fwd_kernel(Params p, int pb, int pe) {
  __shared__ __attribute__((aligned(16))) char smem[SMEM_BYTES];
  cg::grid_group grid = cg::this_grid();
  const int wvs = __builtin_amdgcn_readfirstlane((int)(threadIdx.x >> 6));
  volatile LAS unsigned* xbw = (volatile LAS unsigned*)(smem + SMEM_BYTES - 16);
  if (threadIdx.x < 4) xbw[threadIdx.x] = 0u;
  __syncthreads();
  XcdBarrier xb = xcd_barrier_post(p.bar, xbw);
#pragma unroll 1
  for (int ph = pb; ph < pe; ++ph) {
    int type, l, half;
    decode_phase(ph, type, l, half);
    const int jl = l / 3;
    const float* ng = p.norm_g + (size_t)l * 6 * 1024;
    EA ea; ea.o0 = ea.o1 = nullptr; ea.a0 = ea.a1 = nullptr; ea.i0 = ea.i1 = ea.i2 = ea.i3 = 0;
#if REPEAT_MASK
    const int nrep = ((REPEAT_MASK >> type) & 1) ? 2 : 1;
    for (int rep = 0; rep < nrep; ++rep) {
#endif
    switch (type) {
      case PH_PREP: prep_phase(p, smem, wvs); break;
      case PH_ROW_A: case PH_ROW_B: case PH_ROW_C: case PH_ROW_F: {
        bool first = false, has_f = true, has_next = true;
        int gl = l, gslot = 2, shslot = 3, scslot = 4;
        float coef = 0.5f;
        const float* gf = ng + 1 * 1024; const float* gn = ng + 2 * 1024;
        if (type == PH_ROW_A) { first = l == 0; has_f = l > 0; gl = l - 1; gslot = 8; gf = ng - 1024; gn = ng; shslot = 0; scslot = 1; }
        else if (type == PH_ROW_C) { gslot = 5; coef = 1.0f; gf = ng + 3 * 1024; gn = ng + 4 * 1024; shslot = 6; scslot = 7; }
        else if (type == PH_ROW_F) { gl = 3; gslot = 8; gf = p.norm_g + (size_t)(3 * 6 + 5) * 1024; has_next = false; }
        rowop_phase(p, first, has_f, gl, gslot, coef, gf, has_next, l, gn, shslot, scslot, wvs);
      } break;
      case PH_SWIGLU:
        ea.o0 = p.hid;
        gemm_phase<EPI_SWIGLU, 2, 4, 8>(p, p.h, 1024, p.wt_ffn_in + (size_t)(l * 2 + half) * 5632 * 1024, 1024, 1024, 32, 22, smem, ea, wvs);
        break;
      case PH_FFNOUT: case PH_GM_OUT: case PH_AT_OUT: case PH_SS_OUT: {
        const bf16_t* A; const bf16_t* B; int K;
        if (type == PH_FFNOUT) { A = p.hid; B = p.wt_ffn_out + (size_t)(l * 2 + half) * 1024 * 2816; K = 2816; }
        else if (type == PH_GM_OUT) { A = (const bf16_t*)(p.R + R_GATED_OFF); B = p.wt_gmlp_out + (size_t)jl * 1024 * 3072; K = 3072; }
        else if (type == PH_AT_OUT) { A = (const bf16_t*)(p.R + R_AO_OFF); B = p.wt_ao; K = 1024; }
        else { A = p.hid; B = p.wt_ssm_out; K = 2048; }
        gemm_splitk_phase(p, A, B, K, smem, wvs);
      } break;
      case PH_GM_IN: gmlp_in_phase(p, jl, smem, wvs); break;
      case PH_GM_LN: gmlp_ln_phase(p, jl, smem, wvs); break;
      case PH_GM_SP: gmlp_spatial_phase(p, jl, smem, wvs); break;
      case PH_QKV:
        ea.o0 = p.R + R_QKV_OFF;
        gemm_phase<EPI_QKV, 4, 2, 4>(p, p.h, 1024, p.wt_qkv, 1024, 1024, 32, 12, smem, ea, wvs);
        break;
      case PH_ATT: attn_phase(p, smem, wvs); break;
      case PH_SS_IN:
        ea.o0 = p.R + R_ZX_OFF; ea.o1 = p.R + R_DT_OFF;
        gemm_phase<EPI_SSMIN, 2, 4, 8>(p, p.h, 1024, p.wt_ssm_in, 1024, 1024, 32, 21, smem, ea, wvs);
        break;
      case PH_CONV: conv_phase(p, wvs); break;
      case PH_SSD: ssd_phase(p, smem, wvs); break;
      case PH_POST: ssm_post_phase(p, wvs); break;
      default: break;
    }
#if REPEAT_MASK
    }
#endif
#if EXTRA_SYNCS
    for (int k = 0; k < EXTRA_SYNCS; ++k) xcd_barrier(xb, wvs);
#endif
    if (ph + 1 < pe) { if (pe < 0) grid.sync(); else xcd_barrier(xb, wvs); }
  }
}

#define N_PHASES 44

extern "C" void kernel_launch(void* const* d_in, const int* in_sizes, int n_in, void* d_out, int out_size, void* d_ws,
                              size_t ws_size, hipStream_t stream) {
  Params p{};
  const float* const* in = (const float* const*)d_in;
  p.x_prompt = in[0]; p.x_sample = in[1]; p.cache_k = in[2]; p.cache_v = in[3]; p.state_ssm = in[4]; p.c = in[5]; p.c_ctx = in[6];
  p.w_mod = in[7]; p.b_mod = in[8]; p.norm_g = in[9]; p.ffn_in = in[10]; p.ffn_out = in[11];
  p.gmlp_in = in[12]; p.gmlp_ln_g = in[13]; p.gmlp_ln_b = in[14]; p.gmlp_ws = in[15]; p.gmlp_bs = in[16]; p.gmlp_out = in[17];
  p.attn_qkv = in[18]; p.attn_sink = in[19]; p.attn_out = in[20];
  p.ssm_in = in[21]; p.ssm_conv_w = in[22]; p.ssm_conv_b = in[23]; p.ssm_dt_bias = in[24]; p.ssm_a_log = in[25];
  p.ssm_d = in[26]; p.ssm_norm = in[27]; p.ssm_out = in[28];
  p.out = (float*)d_out;
  char* w = (char*)d_ws;
  size_t off = 0;
  auto take = [&](size_t bytes) { char* r = w + off; off += (bytes + 255) & ~(size_t)255; return r; };
  p.wt_ffn_in = (bf16_t*)take(8ull * 5632 * 1024 * 2);
  p.wt_ffn_out = (bf16_t*)take(8ull * 1024 * 2816 * 2);
  p.wt_gmlp_in = (bf16_t*)take(2ull * 6144 * 1024 * 2);
  p.wt_gmlp_out = (bf16_t*)take(2ull * 1024 * 3072 * 2);
  p.wt_qkv = (bf16_t*)take(1536ull * 1024 * 2);
  p.wt_ao = (bf16_t*)take(1024ull * 1024 * 2);
  p.wt_ssm_in = (bf16_t*)take(5376ull * 1024 * 2);
  p.wt_ssm_out = (bf16_t*)take(1024ull * 2048 * 2);
  p.ws_bf = (bf16_t*)take(2ull * 8 * 128 * 128 * 2);
  p.mod = (float*)take(4ull * 5 * 9216 * 4);
  p.x = (float*)take(8192ull * 1024 * 4);
  p.f = (float*)take(8192ull * 1024 * 4);
  p.stats = (float*)take(2ull * 48 * 8192 * 2 * 4);
  p.h = (bf16_t*)take(8192ull * 1024 * 2);
  p.hid = (bf16_t*)take(8192ull * 2816 * 2);
  p.R = take(R_BYTES);
  p.bar = (unsigned*)take(XCD_BAR_WORDS * 4);
  if (off > ws_size) { fprintf(stderr, "workspace too small: need %zu have %zu\n", off, ws_size); return; }

  hipMemsetAsync(p.bar, 0, XCD_BAR_WORDS * 4, stream);
#if ONE_LAUNCH
  static int grid_blocks = 0;
  if (!grid_blocks) {
    int dev = 0, cus = 0, per_cu = 0;
    hipGetDevice(&dev);
    hipDeviceGetAttribute(&cus, hipDeviceAttributeMultiprocessorCount, dev);
    hipOccupancyMaxActiveBlocksPerMultiprocessor(&per_cu, fwd_kernel, NTHR, 0);
    per_cu = 1;
    grid_blocks = cus * per_cu;
  }
  int pb = 0, pe = N_PHASES;
  void* args[] = {&p, &pb, &pe};
  hipError_t e = hipLaunchCooperativeKernel((void*)fwd_kernel, dim3(grid_blocks), dim3(NTHR), args, 0, stream);
  if (e != hipSuccess) fprintf(stderr, "cooperative launch failed: %s (grid %d)\n", hipGetErrorString(e), grid_blocks);
#else
  for (int ph = 0; ph < N_PHASES; ++ph) fwd_kernel<<<256, NTHR, 0, stream>>>(p, ph, ph + 1);
#endif
}
```

```cpp
#include <hip/hip_runtime.h>
#include <hip/hip_cooperative_groups.h>
#include <cstdio>
#include <cstdint>
namespace cg = cooperative_groups;

#ifndef EXTRA_SYNCS
#define EXTRA_SYNCS 0
#endif
#ifndef REPEAT_MASK
#define REPEAT_MASK 0
#endif
#ifndef ONE_LAUNCH
#define ONE_LAUNCH 1
#endif

typedef unsigned short bf16_t;
using bf16x8 = __attribute__((ext_vector_type(8))) short;
using f32x4  = __attribute__((ext_vector_type(4))) float;
using f32x16 = __attribute__((ext_vector_type(16))) float;

#define NTHR 512
#define HALF_SMEM 70656
#define SMEM_BYTES (147456 + 16)

__device__ __forceinline__ bf16_t f2bf(float f) {
  unsigned u = __float_as_uint(f);
  u += 0x7fffu + ((u >> 16) & 1u);
  return (bf16_t)(u >> 16);
}
__device__ __forceinline__ unsigned cvt_pk_bf16(float lo, float hi) {
  unsigned r;
  asm("v_cvt_pk_bf16_f32 %0, %1, %2" : "=v"(r) : "v"(lo), "v"(hi));
  return r;
}
__device__ __forceinline__ bf16_t f2bf_hw(float f) { return (bf16_t)(cvt_pk_bf16(f, f) & 0xffffu); }
__device__ __forceinline__ float bf2f(bf16_t b) { return __uint_as_float(((unsigned)b) << 16); }
__device__ __forceinline__ unsigned pack2(float a, float b) { return (unsigned)f2bf(a) | ((unsigned)f2bf(b) << 16); }
__device__ __forceinline__ float lo_f(unsigned w) { return __uint_as_float(w << 16); }
__device__ __forceinline__ float hi_f(unsigned w) { return __uint_as_float(w & 0xffff0000u); }
__device__ __forceinline__ float silu_f(float x) { return __fdividef(x, 1.f + __expf(-x)); }
__device__ __forceinline__ float gelu_f(float x) {
  const float z = fabsf(x) * 0.70710678118654752f;
  const float t = __fdividef(1.f, 1.f + 0.3275911f * z);
  const float poly = t * (0.254829592f + t * (-0.284496736f + t * (1.421413741f + t * (-1.453152027f + t * 1.061405429f))));
  const float e = 1.f - poly * __expf(-z * z);
  return 0.5f * x * (1.f + copysignf(e, x));
}

__device__ __forceinline__ int opaque_tid(const int wvs) {
  int t = (wvs << 6) | (int)__builtin_amdgcn_mbcnt_hi(~0u, __builtin_amdgcn_mbcnt_lo(~0u, 0u));
  asm volatile("" : "+v"(t));
  return t;
}

__device__ __forceinline__ float4 nt_load4(const float* p) {
  typedef float v4f __attribute__((ext_vector_type(4)));
  v4f t = __builtin_nontemporal_load((const v4f*)p);
  return make_float4(t.x, t.y, t.z, t.w);
}

struct Params {
  const float *x_prompt, *x_sample, *cache_k, *cache_v, *state_ssm, *c, *c_ctx;
  const float *w_mod, *b_mod, *norm_g, *ffn_in, *ffn_out;
  const float *gmlp_in, *gmlp_ln_g, *gmlp_ln_b, *gmlp_ws, *gmlp_bs, *gmlp_out;
  const float *attn_qkv, *attn_sink, *attn_out;
  const float *ssm_in, *ssm_conv_w, *ssm_conv_b, *ssm_dt_bias, *ssm_a_log, *ssm_d, *ssm_norm, *ssm_out;
  float* out;
  bf16_t *wt_ffn_in, *wt_ffn_out, *wt_gmlp_in, *wt_gmlp_out, *wt_qkv, *wt_ao, *wt_ssm_in, *wt_ssm_out, *ws_bf;
  float *mod, *x, *f, *stats;
  bf16_t *h, *hid;
  char* R;
  unsigned* bar;
};

#define R_U_OFF      0ull
#define R_VT_OFF     50331648ull
#define R_GATED_OFF  100663296ull
#define R_QKV_OFF    0ull
#define R_AO_OFF     25165824ull
#define R_ZX_OFF     0ull
#define R_DT_OFF     83886080ull
#define R_XC_OFF     85983232ull
#define R_Y_OFF      136314880ull
#define R_BYTES      203423744ull

struct TJob { const float* src; bf16_t* dst; int K, N, nmat, perm, dstRows; };

__device__ __forceinline__ TJob get_job(const Params& p, int j) {
  TJob t;
  switch (j) {
    case 0: t.src = p.ffn_in;   t.dst = p.wt_ffn_in;   t.K = 1024; t.N = 5632; t.nmat = 8; t.perm = 1; t.dstRows = 5632; break;
    case 1: t.src = p.ffn_out;  t.dst = p.wt_ffn_out;  t.K = 2816; t.N = 1024; t.nmat = 8; t.perm = 0; t.dstRows = 1024; break;
    case 2: t.src = p.gmlp_in;  t.dst = p.wt_gmlp_in;  t.K = 1024; t.N = 6144; t.nmat = 2; t.perm = 0; t.dstRows = 6144; break;
    case 3: t.src = p.gmlp_out; t.dst = p.wt_gmlp_out; t.K = 3072; t.N = 1024; t.nmat = 2; t.perm = 0; t.dstRows = 1024; break;
    case 4: t.src = p.attn_qkv; t.dst = p.wt_qkv;      t.K = 1024; t.N = 1536; t.nmat = 1; t.perm = 0; t.dstRows = 1536; break;
    case 5: t.src = p.attn_out; t.dst = p.wt_ao;       t.K = 1024; t.N = 1024; t.nmat = 1; t.perm = 0; t.dstRows = 1024; break;
    case 6: t.src = p.ssm_in;   t.dst = p.wt_ssm_in;   t.K = 1024; t.N = 5184; t.nmat = 1; t.perm = 0; t.dstRows = 5376; break;
    default: t.src = p.ssm_out; t.dst = p.wt_ssm_out;  t.K = 2048; t.N = 1024; t.nmat = 1; t.perm = 0; t.dstRows = 1024; break;
  }
  return t;
}

__device__ void prep_phase(const Params& p, char* smem, const int wvs) {
  const int tid = opaque_tid(wvs), half = tid >> 8, tl = tid & 255, lane = tid & 63, wid = tl >> 6;
  const int vb = blockIdx.x * 2 + half, nvb = gridDim.x * 2;
  char* hsm = smem + half * HALF_SMEM;
  float* sc = (float*)smem;
  float* red = sc + 8192;
  for (int i = tid; i < 5120; i += NTHR) {
    int ci = i >> 10, k = i & 1023;
    float v = ci == 0 ? p.c_ctx[k] : p.c[(ci - 1) * 1024 + k];
    sc[k * 8 + ci] = v / (1.f + expf(-v));
  }
  __syncthreads();
  for (int u = blockIdx.x; u < 256; u += gridDim.x) {
    const int l = u >> 6, n0 = (u & 63) * 144, w8 = tid >> 6;
    float4 a0 = make_float4(0.f, 0.f, 0.f, 0.f), a1 = a0, a2 = a0, a3 = a0, a4 = a0;
    if (lane < 36) {
      const float* wp = p.w_mod + ((size_t)l * 1024 + w8 * 128) * 9216 + n0 + lane * 4;
      const float* s0 = sc + w8 * 128 * 8;
#pragma unroll 8
      for (int k = 0; k < 128; ++k) {
        const float4 wv = nt_load4(wp + (size_t)k * 9216);
        const float4 s4 = *(const float4*)(s0 + k * 8);
        const float s5 = s0[k * 8 + 4];
        a0.x += s4.x * wv.x; a0.y += s4.x * wv.y; a0.z += s4.x * wv.z; a0.w += s4.x * wv.w;
        a1.x += s4.y * wv.x; a1.y += s4.y * wv.y; a1.z += s4.y * wv.z; a1.w += s4.y * wv.w;
        a2.x += s4.z * wv.x; a2.y += s4.z * wv.y; a2.z += s4.z * wv.z; a2.w += s4.z * wv.w;
        a3.x += s4.w * wv.x; a3.y += s4.w * wv.y; a3.z += s4.w * wv.z; a3.w += s4.w * wv.w;
        a4.x += s5 * wv.x; a4.y += s5 * wv.y; a4.z += s5 * wv.z; a4.w += s5 * wv.w;
      }
      float* rp = red + (w8 * 5) * 144 + lane * 4;
      *(float4*)(rp) = a0; *(float4*)(rp + 144) = a1; *(float4*)(rp + 288) = a2; *(float4*)(rp + 432) = a3; *(float4*)(rp + 576) = a4;
    }
    __syncthreads();
    for (int i = tid; i < 720; i += NTHR) {
      const int ci = i / 144, col = i - ci * 144;
      float sum = p.b_mod[l * 9216 + n0 + col];
#pragma unroll
      for (int w = 0; w < 8; ++w) sum += red[(w * 5 + ci) * 144 + col];
      p.mod[((size_t)l * 5 + ci) * 9216 + n0 + col] = sum;
    }
    __syncthreads();
  }
  for (int base = blockIdx.x * NTHR; base < 192 * 1024 / 2; base += gridDim.x * NTHR) {
    int i = base + tid;
    if (i < 192 * 1024 / 2) ((unsigned*)(p.wt_ssm_in + 5184 * 1024))[i] = 0u;
  }
  for (int base = blockIdx.x * NTHR; base < 2 * 8 * 128 * 128 / 2; base += gridDim.x * NTHR) {
    int i = base + tid;
    if (i < 2 * 8 * 128 * 128 / 2) {
      float2 v = ((const float2*)p.gmlp_ws)[i];
      ((unsigned*)p.ws_bf)[i] = pack2(v.x, v.y);
    }
  }
  float* sm = (float*)hsm;
  __syncthreads();
#pragma unroll 1
  for (int j = 0; j < 8; ++j) {
    TJob tj = get_job(p, j);
    const int kt_n = tj.K >> 6, nt_n = (tj.N + 127) >> 7, tpm = kt_n * nt_n, ntl = tpm * tj.nmat;
    float4 v[8];
    auto tile_load = [&](int t) {
      int mat = t / tpm, r = t - mat * tpm, nt = r / kt_n, kt = r - nt * kt_n;
      const int col = nt * 128 + (tl & 31) * 4;
      const float* src = tj.src + (size_t)mat * tj.K * tj.N + (size_t)(kt * 64) * tj.N + col;
      if (col < tj.N) {
#pragma unroll
        for (int i = 0; i < 8; ++i) v[i] = nt_load4(src + (size_t)((tl >> 5) + 8 * i) * tj.N);
      }
    };
    {
      const int t = blockIdx.x * 2 + half;
      if (t < ntl) tile_load(t);
    }
    for (int t0 = blockIdx.x * 2; t0 < ntl; t0 += nvb) {
      const int t = t0 + half;
      const bool act = t < ntl;
      int mat = t / tpm, r = t - mat * tpm, nt = r / kt_n, kt = r - nt * kt_n;
      if (act) {
#pragma unroll
        for (int i = 0; i < 8; ++i) {
          int k = (tl >> 5) + 8 * i, cc = (tl & 31) * 4;
          sm[k * 129 + cc] = v[i].x; sm[k * 129 + cc + 1] = v[i].y; sm[k * 129 + cc + 2] = v[i].z; sm[k * 129 + cc + 3] = v[i].w;
        }
      }
      __syncthreads();
      if (t + nvb < ntl) tile_load(t + nvb);
      if (act) {
        int n = tl >> 1, ks = (tl & 1) * 32;
        int dn = nt * 128 + n;
        if (dn < tj.N) {
          unsigned w[16];
#pragma unroll
          for (int e = 0; e < 16; ++e) w[e] = pack2(sm[(ks + 2 * e) * 129 + n], sm[(ks + 2 * e + 1) * 129 + n]);
          if (tj.perm) dn = dn < 2816 ? ((dn >> 5) * 64 + (dn & 31)) : ((((dn - 2816) >> 5) * 64) + 32 + ((dn - 2816) & 31));
          uint4* dp = (uint4*)(tj.dst + ((size_t)mat * tj.dstRows + dn) * tj.K + kt * 64 + ks);
          dp[0] = make_uint4(w[0], w[1], w[2], w[3]);
          dp[1] = make_uint4(w[4], w[5], w[6], w[7]);
          dp[2] = make_uint4(w[8], w[9], w[10], w[11]);
          dp[3] = make_uint4(w[12], w[13], w[14], w[15]);
        }
      }
      __syncthreads();
    }
  }
}

__device__ __forceinline__ void gemm_half(const bf16_t* Ag, int lda, const bf16_t* Bg, int ldb, int K, char* smem,
                                          f32x4 (&acc)[4][4], const int tid) {
  const int lane = tid & 63, wid = tid >> 6, wr = wid >> 1, wc = wid & 1, fr = lane & 15, fq = lane >> 4;
#pragma unroll
  for (int m = 0; m < 4; ++m)
#pragma unroll
    for (int n = 0; n < 4; ++n) acc[m][n] = f32x4{0.f, 0.f, 0.f, 0.f};
  const int r0 = tid >> 3, pos = tid & 7;
  const int cg = (pos ^ ((r0 >> 1) & 7)) * 8;
  const bf16_t* ap = Ag + (size_t)r0 * lda + cg;
  const bf16_t* bp = Bg + (size_t)r0 * ldb + cg;
  const int nk = K >> 6;
  auto stage = [&](int kt, int buf) {
    char* SA = smem + buf * 32768;
    char* SB = SA + 16384;
#pragma unroll
    for (int i = 0; i < 4; ++i) {
      __builtin_amdgcn_global_load_lds((const unsigned*)(ap + (size_t)(32 * i) * lda + kt * 64),
                                       (__attribute__((address_space(3))) unsigned*)(SA + tid * 16 + i * 4096), 16, 0, 0);
      __builtin_amdgcn_global_load_lds((const unsigned*)(bp + (size_t)(32 * i) * ldb + kt * 64),
                                       (__attribute__((address_space(3))) unsigned*)(SB + tid * 16 + i * 4096), 16, 0, 0);
    }
  };
  const int swz = (fr >> 1) & 7;
  const int aoff = (wr * 64 + fr) * 128, boff = (wc * 64 + fr) * 128;
  const int c0 = ((fq) ^ swz) * 16, c1 = ((4 + fq) ^ swz) * 16;
  stage(0, 0);
#pragma unroll 1
  for (int kt = 0; kt < nk; ++kt) {
    asm volatile("s_waitcnt vmcnt(0)" ::: "memory");
    __syncthreads();
    if (kt + 1 < nk) stage(kt + 1, (kt + 1) & 1);
    const char* SA = smem + (kt & 1) * 32768;
    const char* SB = SA + 16384;
    bf16x8 a[4][2], b[4][2];
#pragma unroll
    for (int m = 0; m < 4; ++m) { a[m][0] = *(const bf16x8*)(SA + aoff + m * 2048 + c0); a[m][1] = *(const bf16x8*)(SA + aoff + m * 2048 + c1); }
#pragma unroll
    for (int n = 0; n < 4; ++n) { b[n][0] = *(const bf16x8*)(SB + boff + n * 2048 + c0); b[n][1] = *(const bf16x8*)(SB + boff + n * 2048 + c1); }
#pragma unroll
    for (int kk = 0; kk < 2; ++kk)
#pragma unroll
      for (int m = 0; m < 4; ++m)
#pragma unroll
        for (int n = 0; n < 4; ++n) acc[m][n] = __builtin_amdgcn_mfma_f32_16x16x32_bf16(a[m][kk], b[n][kk], acc[m][n], 0, 0, 0);
  }
  __syncthreads();
}

template <int WM, int WN, int MT>
__device__ __forceinline__ void gemm_big(const bf16_t* Ag, int lda, const bf16_t* Bg, int ldb, int K, char* smem,
                                         f32x4 (&acc)[MT][4], const int tid) {
  constexpr int BMt = WM * MT * 16, BNt = WN * 64;
  constexpr int STAGE_BYTES = (BMt + BNt) * 128;
  const int lane = tid & 63, wid = tid >> 6, wr = wid / WN, wc = wid % WN, fr = lane & 15, fq = lane >> 4;
#pragma unroll
  for (int m = 0; m < MT; ++m)
#pragma unroll
    for (int n = 0; n < 4; ++n) acc[m][n] = f32x4{0.f, 0.f, 0.f, 0.f};
  const int r0 = tid >> 3, pos = tid & 7;
  const int cg = (pos ^ ((r0 >> 1) & 7)) * 8;
  const bf16_t* ap = Ag + (size_t)r0 * lda + cg;
  const bf16_t* bp = Bg + (size_t)r0 * ldb + cg;
  const int nk = K >> 6;
  auto stage = [&](int kt, int buf) {
    char* SA = smem + buf * STAGE_BYTES;
    char* SB = SA + BMt * 128;
#pragma unroll
    for (int i = 0; i < BMt / 64; ++i)
      __builtin_amdgcn_global_load_lds((const unsigned*)(ap + (size_t)(64 * i) * lda + kt * 64),
                                       (__attribute__((address_space(3))) unsigned*)(SA + tid * 16 + i * 8192), 16, 0, 0);
#pragma unroll
    for (int i = 0; i < BNt / 64; ++i)
      __builtin_amdgcn_global_load_lds((const unsigned*)(bp + (size_t)(64 * i) * ldb + kt * 64),
                                       (__attribute__((address_space(3))) unsigned*)(SB + tid * 16 + i * 8192), 16, 0, 0);
  };
  const int swz = (fr >> 1) & 7;
  const int aoff = (wr * MT * 16 + fr) * 128, boff = BMt * 128 + (wc * 64 + fr) * 128;
  const int c0 = ((fq) ^ swz) * 16, c1 = ((4 + fq) ^ swz) * 16;
  stage(0, 0);
#pragma unroll 1
  for (int kt = 0; kt < nk; ++kt) {
    asm volatile("s_waitcnt vmcnt(0)" ::: "memory");
    __syncthreads();
    if (kt + 1 < nk) stage(kt + 1, (kt + 1) & 1);
    const char* S = smem + (kt & 1) * STAGE_BYTES;
#pragma unroll
    for (int kk = 0; kk < 2; ++kk) {
      const int cc = kk ? c1 : c0;
      bf16x8 b[4], a[MT];
#pragma unroll
      for (int n = 0; n < 4; ++n) b[n] = *(const bf16x8*)(S + boff + n * 2048 + cc);
#pragma unroll
      for (int m = 0; m < MT; ++m) a[m] = *(const bf16x8*)(S + aoff + m * 2048 + cc);
#pragma unroll
      for (int m = 0; m < MT; ++m)
#pragma unroll
        for (int n = 0; n < 4; ++n) acc[m][n] = __builtin_amdgcn_mfma_f32_16x16x32_bf16(a[m], b[n], acc[m][n], 0, 0, 0);
    }
  }
  __syncthreads();
}

template <int WM, int WN, int MT>
__device__ __forceinline__ void gemm_issue01(const bf16_t* Ag, int lda, const bf16_t* Bg, int ldb, char* smem, const int tid) {
  constexpr int BMt = WM * MT * 16, BNt = WN * 64;
  constexpr int STG = (BMt + BNt) * 64;
  constexpr int GA = BMt / 128, GB = BNt / 128;
  const int r0 = tid >> 2, pos = tid & 3;
  const int cg = (pos ^ (((r0 >> 3) & 1) * 3)) * 8;
  const bf16_t* ap = Ag + (size_t)r0 * lda + cg;
  const bf16_t* bp = Bg + (size_t)r0 * ldb + cg;
#pragma unroll
  for (int kt = 0; kt < 2; ++kt) {
    char* SA = smem + kt * STG;
    char* SB = SA + BMt * 64;
#pragma unroll
    for (int i = 0; i < GA; ++i)
      __builtin_amdgcn_global_load_lds((const unsigned*)(ap + (size_t)(128 * i) * lda + kt * 32),
                                       (__attribute__((address_space(3))) unsigned*)(SA + tid * 16 + i * 8192), 16, 0, 0);
#pragma unroll
    for (int i = 0; i < GB; ++i)
      __builtin_amdgcn_global_load_lds((const unsigned*)(bp + (size_t)(128 * i) * ldb + kt * 32),
                                       (__attribute__((address_space(3))) unsigned*)(SB + tid * 16 + i * 8192), 16, 0, 0);
  }
}

template <int WM, int WN, int MT, bool PRE = false>
__device__ __forceinline__ void gemm_pipe(const bf16_t* Ag, int lda, const bf16_t* Bg, int ldb, int K, char* smem,
                                          f32x4 (&acc)[MT][4], const int tid) {
  constexpr int BMt = WM * MT * 16, BNt = WN * 64;
  constexpr int STG = (BMt + BNt) * 64;
  constexpr int GA = BMt / 128, GB = BNt / 128, G = GA + GB;
  const int lane = tid & 63, wid = tid >> 6, wr = wid / WN, wc = wid % WN, fr = lane & 15, fq = lane >> 4;
#pragma unroll
  for (int m = 0; m < MT; ++m)
#pragma unroll
    for (int n = 0; n < 4; ++n) acc[m][n] = f32x4{0.f, 0.f, 0.f, 0.f};
  const int r0 = tid >> 2, pos = tid & 3;
  const int cg = (pos ^ (((r0 >> 3) & 1) * 3)) * 8;
  const unsigned toffA = (unsigned)(r0 * lda + cg) * 2u, toffB = (unsigned)(r0 * ldb + cg) * 2u;
  auto stageA = [&](int kt) {
    char* SA = smem + (kt & 3) * STG;
#pragma unroll
    for (int i = 0; i < GA; ++i)
      __builtin_amdgcn_global_load_lds((const unsigned*)((const char*)Ag + ((size_t)(128 * i) * lda + kt * 32) * 2 + toffA),
                                       (__attribute__((address_space(3))) unsigned*)(SA + tid * 16 + i * 8192), 16, 0, 0);
  };
  auto stageB = [&](int kt) {
    char* SB = smem + (kt & 3) * STG + BMt * 64;
#pragma unroll
    for (int i = 0; i < GB; ++i)
      __builtin_amdgcn_global_load_lds((const unsigned*)((const char*)Bg + ((size_t)(128 * i) * ldb + kt * 32) * 2 + toffB),
                                       (__attribute__((address_space(3))) unsigned*)(SB + tid * 16 + i * 8192), 16, 0, 0);
  };
  auto stage = [&](int kt) { stageA(kt); stageB(kt); };
  const int cpos = (fq ^ (((fr >> 3) & 1) * 3)) * 16;
  const int aoff = (wr * MT * 16 + fr) * 64 + cpos, boff = BMt * 64 + (wc * 64 + fr) * 64 + cpos;
  const int nk = K >> 5;
#define GP_RDB(kt, B_)                                                                   \
  {                                                                                      \
    const char* S_ = smem + ((kt) & 3) * STG;                                            \
    _Pragma("unroll") for (int n = 0; n < 4; ++n) B_[n] = *(const bf16x8*)(S_ + boff + n * 1024);  \
  }
#define GP_RDA(kt, A_, mb)                                                               \
  {                                                                                      \
    const char* S_ = smem + ((kt) & 3) * STG;                                            \
    _Pragma("unroll") for (int m = 0; m < MH; ++m) A_[m] = *(const bf16x8*)(S_ + aoff + ((mb) + m) * 1024); \
  }
#define GP_MMA(A_, B_, mb)                                                               \
  {                                                                                      \
    _Pragma("unroll") for (int m = 0; m < MH; ++m)                                       \
      _Pragma("unroll") for (int n = 0; n < 4; ++n)                                      \
        acc[(mb) + m][n] = __builtin_amdgcn_mfma_f32_16x16x32_bf16(A_[m], B_[n], acc[(mb) + m][n], 0, 0, 0); \
  }
#define GP_STEP(kt, Bc, Bn)                                                              \
  {                                                                                      \
    GP_RDA(kt, ahi, MH);                                                                 \
    __builtin_amdgcn_sched_barrier(0);                                                   \
    GP_MMA(alo, Bc, 0);                                                                  \
    __builtin_amdgcn_sched_barrier(0);                                                   \
    if ((kt) + 2 < nk) stageB((kt) + 2);                          \
    if ((kt) + 1 < nk) {                                                                 \
      if ((kt) + 2 < nk) asm volatile("s_waitcnt vmcnt(%0)" ::"n"(G) : "memory");        \
      else asm volatile("s_waitcnt vmcnt(0)" ::: "memory");                              \
    }                                                                                    \
    __builtin_amdgcn_s_barrier();                                                        \
    if ((kt) + 1 < nk) { GP_RDB((kt) + 1, Bn); GP_RDA((kt) + 1, alo, 0); }               \
    __builtin_amdgcn_sched_barrier(0);                                                   \
    GP_MMA(ahi, Bc, MH);                                                                 \
    __builtin_amdgcn_sched_barrier(0);                                                   \
    if ((kt) + 3 < nk) stageA((kt) + 3);                          \
  }
  constexpr int MH = MT / 2;
  if constexpr (PRE) {
    __syncthreads();
    stageA(2);
    asm volatile("s_waitcnt vmcnt(%0)" ::"n"(GA) : "memory");
  } else {
    __syncthreads();
    stage(0); stage(1); stageA(2);
    asm volatile("s_waitcnt vmcnt(%0)" ::"n"(G + GA) : "memory");
  }
  __builtin_amdgcn_s_barrier();
  bf16x8 alo[MH], ahi[MH], b0[4], b1[4];
  GP_RDB(0, b0);
  GP_RDA(0, alo, 0);
#pragma unroll 1
  for (int kt = 0; kt < nk; kt += 2) {
    GP_STEP(kt, b0, b1);
    GP_STEP(kt + 1, b1, b0);
  }
#undef GP_RDB
#undef GP_RDA
#undef GP_MMA
#undef GP_STEP
  __syncthreads();
}

enum { EPI_SWIGLU = 0, EPI_F32, EPI_GELU_U, EPI_GELU_VT, EPI_SPATIAL, EPI_QKV, EPI_SSMIN, EPI_PART };

struct EA { void* o0; void* o1; const void* a0; const void* a1; int i0, i1, i2, i3; };

__device__ __forceinline__ void flush64_bf16(const bf16_t* S, bf16_t* g, size_t ld, int lane) {
#pragma unroll
  for (int it = 0; it < 8; ++it) {
    const int r = it * 8 + (lane >> 3), c = (lane & 7) * 8;
    *(uint4*)(g + (size_t)r * ld + c) = *(const uint4*)(S + r * 72 + c);
  }
}

template <int EPI, int WN, int MT>
__device__ __forceinline__ void gemm_epi(const Params& p, f32x4 (&acc)[MT][4], int row0, int col0, const EA& ea, const int tid,
                                         char* smem, const int wv) {
  const int lane = tid & 63, wid = tid >> 6, wr = wid / WN, wc = wid % WN, fr = lane & 15, fq = lane >> 4;
  const int rb = row0 + wr * (MT * 16) + fq * 4, cb = col0 + wc * 64 + fr;
  const int wrow0 = row0 + wr * (MT * 16), wcol0 = col0 + wc * 64;
  __builtin_amdgcn_sched_barrier(0);
  if constexpr (EPI == EPI_SWIGLU) {
    bf16_t* hid = (bf16_t*)ea.o0;
    bf16_t* S = (bf16_t*)(smem + 65536 + wv * (MT * 16 * 80));
#pragma unroll
    for (int m = 0; m < MT; ++m)
#pragma unroll
      for (int n = 0; n < 2; ++n)
#pragma unroll
        for (int j = 0; j < 4; ++j) {
          float g = acc[m][n][j], u = acc[m][n + 2][j];
          S[(m * 16 + fq * 4 + j) * 40 + n * 16 + fr] = f2bf_hw(silu_f(g) * u);
        }
    bf16_t* gp = hid + (size_t)wrow0 * 2816 + (col0 >> 1) + wc * 32;
#pragma unroll
    for (int it = 0; it < MT; ++it) {
      const int r = it * 16 + (lane >> 2), c = (lane & 3) * 8;
      *(uint4*)(gp + (size_t)r * 2816 + c) = *(const uint4*)(S + r * 40 + c);
    }
  } else if constexpr (EPI == EPI_F32) {
    static_assert(EPI != EPI_F32 || MT == 4, "f32 epilogue staged for 64-row wave tiles");
    float* o = (float*)ea.o0;
    float* S = (float*)(smem + wv * 17408);
#pragma unroll
    for (int m = 0; m < MT; ++m)
#pragma unroll
      for (int n = 0; n < 4; ++n)
#pragma unroll
        for (int j = 0; j < 4; ++j) S[(m * 16 + fq * 4 + j) * 68 + n * 16 + fr] = acc[m][n][j];
    float* gp = o + (size_t)wrow0 * 1024 + wcol0;
#pragma unroll
    for (int it = 0; it < 16; ++it) {
      const int r = it * 4 + (lane >> 4), c = (lane & 15) * 4;
      *(float4*)(gp + (size_t)r * 1024 + c) = *(const float4*)(S + r * 68 + c);
    }
  } else if constexpr (EPI == EPI_PART) {
    bf16_t* o = (bf16_t*)ea.o0;
    bf16_t* S = (bf16_t*)(smem + 65536 + wv * 9216);
#pragma unroll
    for (int mh = 0; mh < MT / 4; ++mh) {
#pragma unroll
      for (int m = 0; m < 4; ++m)
#pragma unroll
        for (int n = 0; n < 4; ++n)
#pragma unroll
          for (int j = 0; j < 4; ++j) S[(m * 16 + fq * 4 + j) * 72 + n * 16 + fr] = f2bf_hw(acc[mh * 4 + m][n][j]);
      flush64_bf16(S, o + (size_t)(wrow0 + mh * 64) * 1024 + wcol0, 1024, lane);
    }
  } else if constexpr (EPI == EPI_GELU_U) {
    bf16_t* o = (bf16_t*)ea.o0;
    bf16_t* S = (bf16_t*)(smem + 65536 + wv * 9216);
#pragma unroll
    for (int mh = 0; mh < MT / 4; ++mh) {
#pragma unroll
      for (int m = 0; m < 4; ++m)
#pragma unroll
        for (int n = 0; n < 4; ++n)
#pragma unroll
          for (int j = 0; j < 4; ++j) S[(m * 16 + fq * 4 + j) * 72 + n * 16 + fr] = f2bf(gelu_f(acc[mh * 4 + m][n][j]));
      flush64_bf16(S, o + (size_t)(wrow0 + mh * 64) * 3072 + wcol0, 3072, lane);
    }
  } else if constexpr (EPI == EPI_GELU_VT) {
    bf16_t* o = (bf16_t*)ea.o0;
    float* stats = (float*)ea.o1;
    bf16_t* S = (bf16_t*)(smem + 65536 + wv * 9216);
    float s1[4] = {0.f, 0.f, 0.f, 0.f}, s2[4] = {0.f, 0.f, 0.f, 0.f};
#pragma unroll
    for (int mh = 0; mh < MT / 4; ++mh) {
#pragma unroll
      for (int m = 0; m < 4; ++m)
#pragma unroll
        for (int n = 0; n < 4; ++n)
#pragma unroll
          for (int j = 0; j < 4; ++j) {
            float g = gelu_f(acc[mh * 4 + m][n][j]);
            S[(m * 16 + fq * 4 + j) * 72 + n * 16 + fr] = f2bf(g);
            s1[n] += g; s2[n] += g * g;
          }
      flush64_bf16(S, o + (size_t)(wrow0 + mh * 64) * 8192 + wcol0, 8192, lane);
    }
#pragma unroll
    for (int n = 0; n < 4; ++n) {
      float a1 = s1[n], a2 = s2[n];
      a1 += __shfl_xor(a1, 16); a2 += __shfl_xor(a2, 16);
      a1 += __shfl_xor(a1, 32); a2 += __shfl_xor(a2, 32);
      if (fq == 0) ((float2*)stats)[(size_t)(row0 / (MT * 16) + wr) * 8192 + cb + n * 16] = make_float2(a1, a2);
    }
  } else if constexpr (EPI == EPI_SPATIAL) {
    bf16_t* o = (bf16_t*)ea.o0;
    const bf16_t* u = (const bf16_t*)ea.a0;
    const float* bs = (const float*)ea.a1 + ea.i0 * 128;
    bf16_t* S = (bf16_t*)(smem + 65536 + wv * 9216);
    const bf16_t* up = u + (size_t)wrow0 * 3072 + wcol0;
#pragma unroll
    for (int it = 0; it < 8; ++it) {
      const int r = it * 8 + (lane >> 3), c = (lane & 7) * 8;
      *(uint4*)(S + r * 72 + c) = *(const uint4*)(up + (size_t)r * 3072 + c);
    }
#pragma unroll
    for (int m = 0; m < MT; ++m)
#pragma unroll
      for (int j = 0; j < 4; ++j) {
        const int rl = m * 16 + fq * 4 + j;
        const float bias = bs[(wrow0 + rl) & 127];
#pragma unroll
        for (int n = 0; n < 4; ++n) {
          bf16_t* sp = S + rl * 72 + n * 16 + fr;
          *sp = f2bf((acc[m][n][j] + bias) * bf2f(*sp));
        }
      }
    flush64_bf16(S, o + (size_t)wrow0 * 3072 + wcol0, 3072, lane);
  } else if constexpr (EPI == EPI_QKV) {
    static_assert(EPI != EPI_QKV || MT == 4, "qkv epilogue staged for 64-row wave tiles");
    bf16_t* o = (bf16_t*)ea.o0;
    bf16_t* S = (bf16_t*)(smem + 65536 + wv * 9216);
    const int slot = (col0 + wc * 64) >> 6;
    const float inv = __expf(-(float)fr * (9.210340371976184f / 16.f));
#pragma unroll
    for (int m = 0; m < MT; ++m)
#pragma unroll
      for (int j = 0; j < 4; ++j) {
        int r = rb + m * 16 + j;
        float v0 = acc[m][0][j], v1 = acc[m][1][j], v2 = acc[m][2][j], v3 = acc[m][3][j];
        if (r >= 4096) {
          if (slot < 20) {
            int t = (r - 4096) & 1023;
            float sr, cr, sc_, cc_;
            __sincosf((float)(t >> 6) * inv, &sr, &cr);
            __sincosf((float)(t & 63) * inv, &sc_, &cc_);
            float n0 = v0 * cr - v1 * sr, n1 = v1 * cr + v0 * sr;
            float n2 = v2 * cc_ - v3 * sc_, n3 = v3 * cc_ + v2 * sc_;
            v0 = n0; v1 = n1; v2 = n2; v3 = n3;
          }
        } else if (slot >= 16) {
          float* oc = p.out + 8388608 + (slot >= 20 ? 1048576 : 0) + ((size_t)r * 4 + ((slot - 16) & 3)) * 64 + fr;
          oc[0] = v0; oc[16] = v1; oc[32] = v2; oc[48] = v3;
        }
        bf16_t* sp = S + (m * 16 + fq * 4 + j) * 72 + fr;
        sp[0] = f2bf_hw(v0); sp[16] = f2bf_hw(v1); sp[32] = f2bf_hw(v2); sp[48] = f2bf_hw(v3);
      }
    flush64_bf16(S, o + (size_t)wrow0 * 1536 + wcol0, 1536, lane);
  } else if constexpr (EPI == EPI_SSMIN) {
    bf16_t* o = (bf16_t*)ea.o0;
    float* dtb = (float*)ea.o1;
    if (wcol0 < 5120) {
      bf16_t* S = (bf16_t*)(smem + 65536 + wv * 9216);
#pragma unroll
      for (int mh = 0; mh < MT / 4; ++mh) {
#pragma unroll
        for (int m = 0; m < 4; ++m)
#pragma unroll
          for (int n = 0; n < 4; ++n)
#pragma unroll
            for (int j = 0; j < 4; ++j) S[(m * 16 + fq * 4 + j) * 72 + n * 16 + fr] = f2bf(acc[mh * 4 + m][n][j]);
        flush64_bf16(S, o + (size_t)(wrow0 + mh * 64) * 5120 + wcol0, 5120, lane);
      }
    } else if (wcol0 == 5120) {
#pragma unroll
      for (int n = 0; n < 4; ++n) {
        int hh = n * 16 + fr;
        float bias = p.ssm_dt_bias[hh];
#pragma unroll
        for (int m = 0; m < MT; ++m)
#pragma unroll
          for (int j = 0; j < 4; ++j) {
            float xv = acc[m][n][j] + bias;
            float ev = __expf(xv);
            float sp = xv > 20.f ? xv : (ev < 0.01f ? ev * (1.f - ev * (0.5f - ev * 0.33333333f)) : __logf(1.f + ev));
            dtb[(size_t)(rb + m * 16 + j) * 64 + hh] = sp;
          }
      }
    }
  }
}

template <int EPI, int WM, int WN, int MT>
__device__ void gemm_phase(const Params& p, const bf16_t* A, int lda, const bf16_t* Bt, int ldb, int K, int tm, int tn,
                           char* smem, EA ea, const int wvs) {
  constexpr int BMt = WM * MT * 16, BNt = WN * 64;
  const int nt = tm * tn;
  const int tid = opaque_tid(wvs);
  constexpr bool OVL = (EPI == EPI_SWIGLU);
  int t = blockIdx.x;
  if constexpr (OVL) {
    if (t < nt) {
      __syncthreads();
      gemm_issue01<WM, WN, MT>(A + (size_t)(t % tm) * BMt * lda, lda, Bt + (size_t)(t / tm) * BNt * ldb, ldb, smem, tid);
    }
  }
  for (; t < nt; t += gridDim.x) {
    const int tr = t % tm, tc = t / tm;
    f32x4 acc[MT][4];
    gemm_pipe<WM, WN, MT, OVL>(A + (size_t)tr * BMt * lda, lda, Bt + (size_t)tc * BNt * ldb, ldb, K, smem, acc, tid);
    if constexpr (OVL) {
      const int t2 = t + gridDim.x;
      if (t2 < nt)
        gemm_issue01<WM, WN, MT>(A + (size_t)(t2 % tm) * BMt * lda, lda, Bt + (size_t)(t2 / tm) * BNt * ldb, ldb, smem, tid);
    }
    gemm_epi<EPI, WN, MT>(p, acc, tr * BMt, tc * BNt, ea, tid, smem, tid >> 6);
  }
}

template <int K>
__device__ __forceinline__ void gemm_splitk_body(const Params& p, const bf16_t* A, const bf16_t* Bt, char* smem, const int tid) {
  constexpr int Kh = K / 2;
  EA ea; ea.o1 = nullptr; ea.a0 = ea.a1 = nullptr; ea.i0 = ea.i1 = ea.i2 = ea.i3 = 0;
  for (int t = blockIdx.x; t < 256; t += gridDim.x) {
    const int tr = t & 31, tc = (t >> 5) & 3, kh = t >> 7;
    f32x4 acc[8][4];
    gemm_pipe<2, 4, 8>(A + (size_t)tr * 256 * K + kh * Kh, K, Bt + (size_t)tc * 256 * K + kh * Kh, K, Kh, smem, acc, tid);
    ea.o0 = (bf16_t*)p.f + (size_t)kh * 8192 * 1024;
    gemm_epi<EPI_PART, 4, 8>(p, acc, tr * 256, tc * 256, ea, tid, smem, tid >> 6);
  }
}
__device__ void gemm_splitk_phase(const Params& p, const bf16_t* A, const bf16_t* Bt, int K, char* smem, const int wvs) {
  const int tid = opaque_tid(wvs);
  if (K == 2816) gemm_splitk_body<2816>(p, A, Bt, smem, tid);
  else if (K == 3072) gemm_splitk_body<3072>(p, A, Bt, smem, tid);
  else if (K == 2048) gemm_splitk_body<2048>(p, A, Bt, smem, tid);
  else gemm_splitk_body<1024>(p, A, Bt, smem, tid);
}

__device__ void rowop_phase(const Params& p, bool first, bool has_f, int gl, int gslot, float coef, const float* gf,
                            bool has_next, int nl, const float* gn, int shslot, int scslot, const int wvs) {
  const int tid = opaque_tid(wvs); const int lane = tid & 63, wid = tid >> 6;
  for (int row = blockIdx.x * 8 + wid; row < 8192; row += gridDim.x * 8) {
    const int ci = row < 4096 ? 0 : 1 + ((row - 4096) >> 10);
    const float* xin = first ? (row < 4096 ? p.x_prompt + (size_t)row * 1024 : p.x_sample + (size_t)(row - 4096) * 1024)
                             : p.x + (size_t)row * 1024;
    float4 xv[4];
#pragma unroll
    for (int i = 0; i < 4; ++i) xv[i] = *(const float4*)(xin + i * 256 + lane * 4);
    if (has_f) {
      float4 fv[4];
      float ss = 0.f;
      const bf16_t* f0 = (const bf16_t*)p.f + (size_t)row * 1024;
      const bf16_t* f1 = f0 + (size_t)8192 * 1024;
#pragma unroll
      for (int i = 0; i < 4; ++i) {
        const uint2 q0 = *(const uint2*)(f0 + i * 256 + lane * 4), q1 = *(const uint2*)(f1 + i * 256 + lane * 4);
        fv[i] = make_float4(lo_f(q0.x) + lo_f(q1.x), hi_f(q0.x) + hi_f(q1.x), lo_f(q0.y) + lo_f(q1.y), hi_f(q0.y) + hi_f(q1.y));
        ss += fv[i].x * fv[i].x + fv[i].y * fv[i].y + fv[i].z * fv[i].z + fv[i].w * fv[i].w;
      }
#pragma unroll
      for (int o = 32; o > 0; o >>= 1) ss += __shfl_xor(ss, o);
      float rstd = rsqrtf(ss * (1.f / 1024.f) + 1e-6f) * coef;
      const float* gate = p.mod + ((size_t)(gl * 5 + ci) * 9 + gslot) * 1024;
#pragma unroll
      for (int i = 0; i < 4; ++i) {
        float4 g = *(const float4*)(gate + i * 256 + lane * 4);
        float4 w = *(const float4*)(gf + i * 256 + lane * 4);
        xv[i].x += g.x * fv[i].x * rstd * w.x; xv[i].y += g.y * fv[i].y * rstd * w.y;
        xv[i].z += g.z * fv[i].z * rstd * w.z; xv[i].w += g.w * fv[i].w * rstd * w.w;
      }
    }
    if (!has_next) {
#pragma unroll
      for (int i = 0; i < 4; ++i) *(float4*)(p.out + (size_t)row * 1024 + i * 256 + lane * 4) = xv[i];
    } else {
      float ss = 0.f;
#pragma unroll
      for (int i = 0; i < 4; ++i) {
        *(float4*)(p.x + (size_t)row * 1024 + i * 256 + lane * 4) = xv[i];
        ss += xv[i].x * xv[i].x + xv[i].y * xv[i].y + xv[i].z * xv[i].z + xv[i].w * xv[i].w;
      }
#pragma unroll
      for (int o = 32; o > 0; o >>= 1) ss += __shfl_xor(ss, o);
      float rstd = rsqrtf(ss * (1.f / 1024.f) + 1e-6f);
      const float* sh = p.mod + ((size_t)(nl * 5 + ci) * 9 + shslot) * 1024;
      const float* scl = p.mod + ((size_t)(nl * 5 + ci) * 9 + scslot) * 1024;
#pragma unroll
      for (int i = 0; i < 4; ++i) {
        float4 g = *(const float4*)(gn + i * 256 + lane * 4);
        float4 s = *(const float4*)(sh + i * 256 + lane * 4);
        float4 c = *(const float4*)(scl + i * 256 + lane * 4);
        float h0 = xv[i].x * rstd * g.x * (1.f + c.x) + s.x, h1 = xv[i].y * rstd * g.y * (1.f + c.y) + s.y;
        float h2 = xv[i].z * rstd * g.z * (1.f + c.z) + s.z, h3 = xv[i].w * rstd * g.w * (1.f + c.w) + s.w;
        *(uint2*)(p.h + (size_t)row * 1024 + i * 256 + lane * 4) = make_uint2(cvt_pk_bf16(h0, h1), cvt_pk_bf16(h2, h3));
      }
    }
  }
}

__device__ void gmlp_ln_phase(const Params& p, int jl, char* smem, const int wvs) {
  float* sMu = (float*)smem;
  float* sRs = sMu + 32;
  bf16_t* vT = (bf16_t*)(p.R + R_VT_OFF);
  const float2* part = (const float2*)p.stats + (size_t)jl * 48 * 8192;
  const float* lg = p.gmlp_ln_g + jl * 3072;
  const float* lb = p.gmlp_ln_b + jl * 3072;
  const int tid = opaque_tid(wvs);
  for (int u = blockIdx.x; u < 256; u += gridDim.x) {
    const int t0 = u * 32;
    __syncthreads();
    if (tid < 32) {
      float s1 = 0.f, s2 = 0.f;
      for (int k = 0; k < 24; ++k) { float2 v = part[(size_t)k * 8192 + t0 + tid]; s1 += v.x; s2 += v.y; }
      float mu = s1 * (1.f / 3072.f);
      sMu[tid] = mu;
      sRs[tid] = rsqrtf(fmaxf(s2 * (1.f / 3072.f) - mu * mu, 0.f) + 1e-6f);
    }
    __syncthreads();
    const int tq = tid & 3, nr = tid >> 2;
    float mu[8], rs[8];
#pragma unroll
    for (int e = 0; e < 8; ++e) { mu[e] = sMu[tq * 8 + e]; rs[e] = sRs[tq * 8 + e]; }
#pragma unroll 4
    for (int it = 0; it < 24; ++it) {
      const int n = it * 128 + nr;
      bf16_t* ptr = vT + (size_t)n * 8192 + t0 + tq * 8;
      uint4 v = *(uint4*)ptr;
      const float g = lg[n], b = lb[n];
      unsigned w[4] = {v.x, v.y, v.z, v.w};
      unsigned o[4];
#pragma unroll
      for (int e = 0; e < 4; ++e)
        o[e] = pack2((lo_f(w[e]) - mu[2 * e]) * rs[2 * e] * g + b, (hi_f(w[e]) - mu[2 * e + 1]) * rs[2 * e + 1] * g + b);
      *(uint4*)ptr = make_uint4(o[0], o[1], o[2], o[3]);
    }
  }
}

__device__ void gmlp_spatial_phase(const Params& p, int jl, char* smem, const int wvs) {
  const bf16_t* vT = (const bf16_t*)(p.R + R_VT_OFF);
  const bf16_t* ug = (const bf16_t*)(p.R + R_U_OFF);
  bf16_t* og = (bf16_t*)(p.R + R_GATED_OFF);
  const float2* part = (const float2*)p.stats + (size_t)jl * 48 * 8192;
  const float* lg = p.gmlp_ln_g + jl * 3072;
  const float* lb = p.gmlp_ln_b + jl * 3072;
  const int tid = opaque_tid(wvs), half = tid >> 8, tl = tid & 255;
  const int lane = tl & 63, wid = tl >> 6, wr = wid >> 1, wc = wid & 1, fr = lane & 15, fq = lane >> 4;
  char* hsm = smem + half * 65536;
  float* sMu = (float*)(smem + 139264 + half * 4096);
  float* sRs = sMu + 128;
  float* sS1 = sRs + 128;
  float* sS2 = sS1 + 128;
  const int swz = (fr >> 1) & 7;
  const int aoff = (wr * 64 + fr) * 128, boff = 16384 + (wc * 64 + fr) * 128;
  const int c0 = ((fq) ^ swz) * 16, c1 = ((4 + fq) ^ swz) * 16;
  for (int t0 = blockIdx.x * 2; t0 < 1536; t0 += gridDim.x * 2) {
    const int t = t0 + half;
    const int c = t & 63, r = t >> 6, g = r / 3, nt = r - g * 3;
    const bf16_t* A = p.ws_bf + ((size_t)jl * 8 + g) * 128 * 128;
    const bf16_t* B = vT + (size_t)(g * 384 + nt * 128) * 8192 + c * 128;
    __syncthreads();
    {
      const int r0 = tl >> 3, pos = tl & 7;
      const int cg = (pos ^ ((r0 >> 1) & 7)) * 8;
      const bf16_t* bp = B + (size_t)r0 * 8192 + cg;
#pragma unroll
      for (int kt = 0; kt < 2; ++kt)
#pragma unroll
        for (int i = 0; i < 4; ++i)
          __builtin_amdgcn_global_load_lds((const unsigned*)(bp + (size_t)(32 * i) * 8192 + kt * 64),
                                           (__attribute__((address_space(3))) unsigned*)(hsm + kt * 32768 + 16384 + tl * 16 + i * 4096), 16, 0, 0);
    }
    if (tl < 128) {
      float s1 = 0.f, s2 = 0.f;
      for (int k = 0; k < 24; ++k) { float2 v = part[(size_t)k * 8192 + c * 128 + tl]; s1 += v.x; s2 += v.y; }
      const float mu = s1 * (1.f / 3072.f);
      sMu[tl] = mu;
      sRs[tl] = rsqrtf(fmaxf(s2 * (1.f / 3072.f) - mu * mu, 0.f) + 1e-6f);
    }
    __syncthreads();
#pragma unroll
    for (int i = 0; i < 8; ++i) {
      const int row = (tl >> 4) + 16 * i, kc = tl & 15;
      const uint4 wv = *(const uint4*)(A + row * 128 + kc * 8);
      const unsigned w[4] = {wv.x, wv.y, wv.z, wv.w};
      unsigned o[4];
      float a1 = 0.f, a2 = 0.f;
#pragma unroll
      for (int e = 0; e < 4; ++e) {
        const int j = kc * 8 + 2 * e;
        const float w0 = lo_f(w[e]), w1 = hi_f(w[e]);
        const float q0 = w0 * sRs[j], q1 = w1 * sRs[j + 1];
        o[e] = pack2(q0, q1);
        a1 += q0 * sMu[j] + q1 * sMu[j + 1];
        a2 += w0 + w1;
      }
      *(uint4*)(hsm + (kc >> 3) * 32768 + row * 128 + (((kc & 7) ^ ((row >> 1) & 7)) * 16)) = make_uint4(o[0], o[1], o[2], o[3]);
#pragma unroll
      for (int m = 1; m < 16; m <<= 1) { a1 += __shfl_xor(a1, m); a2 += __shfl_xor(a2, m); }
      if (kc == 0) { sS1[row] = a1; sS2[row] = a2; }
    }
    asm volatile("s_waitcnt vmcnt(0)" ::: "memory");
    __syncthreads();
    f32x4 acc[4][4];
#pragma unroll
    for (int m = 0; m < 4; ++m)
#pragma unroll
      for (int n = 0; n < 4; ++n) acc[m][n] = f32x4{0.f, 0.f, 0.f, 0.f};
#pragma unroll
    for (int kt = 0; kt < 2; ++kt) {
      const char* S = hsm + kt * 32768;
#pragma unroll
      for (int kk = 0; kk < 2; ++kk) {
        const int cc = kk ? c1 : c0;
        bf16x8 a[4], bb[4];
#pragma unroll
        for (int m = 0; m < 4; ++m) a[m] = *(const bf16x8*)(S + aoff + m * 2048 + cc);
#pragma unroll
        for (int n = 0; n < 4; ++n) bb[n] = *(const bf16x8*)(S + boff + n * 2048 + cc);
#pragma unroll
        for (int m = 0; m < 4; ++m)
#pragma unroll
          for (int n = 0; n < 4; ++n) acc[m][n] = __builtin_amdgcn_mfma_f32_16x16x32_bf16(a[m], bb[n], acc[m][n], 0, 0, 0);
      }
    }
    __syncthreads();
    {
      const int wv = tid >> 6;
      bf16_t* S = (bf16_t*)(smem + 65536 + wv * 9216);
      const int wrow0 = c * 128 + wr * 64, wcol0 = g * 384 + nt * 128 + wc * 64;
      const bf16_t* up = ug + (size_t)wrow0 * 3072 + wcol0;
#pragma unroll
      for (int it = 0; it < 8; ++it) {
        const int rr = it * 8 + (lane >> 3), cc = (lane & 7) * 8;
        *(uint4*)(S + rr * 72 + cc) = *(const uint4*)(up + (size_t)rr * 3072 + cc);
      }
      const float* bs = p.gmlp_bs + jl * 1024 + g * 128;
      float lgn[4], lbn[4];
#pragma unroll
      for (int n = 0; n < 4; ++n) { lgn[n] = lg[wcol0 + n * 16 + fr]; lbn[n] = lb[wcol0 + n * 16 + fr]; }
#pragma unroll
      for (int m = 0; m < 4; ++m)
#pragma unroll
        for (int j = 0; j < 4; ++j) {
          const int rl = m * 16 + fq * 4 + j, i = wr * 64 + rl;
          const float s1 = sS1[i], s2 = sS2[i], bias = bs[i];
#pragma unroll
          for (int n = 0; n < 4; ++n) {
            bf16_t* sp = S + rl * 72 + n * 16 + fr;
            const float val = lgn[n] * (acc[m][n][j] - s1) + lbn[n] * s2 + bias;
            *sp = f2bf(val * bf2f(*sp));
          }
        }
      flush64_bf16(S, og + (size_t)wrow0 * 3072 + wcol0, 3072, lane);
    }
  }
}

__device__ void gmlp_in_phase(const Params& p, int jl, char* smem, const int wvs) {
  const bf16_t* W = p.wt_gmlp_in + (size_t)jl * 6144 * 1024;
  EA ea; ea.a0 = ea.a1 = nullptr; ea.i0 = ea.i1 = ea.i2 = ea.i3 = 0;
  const int tid = opaque_tid(wvs);
  for (int t = blockIdx.x; t < 384; t += gridDim.x) {
    f32x4 acc[8][4];
    int tr = t & 31, tc = t >> 5;
    gemm_pipe<2, 4, 8>(p.h + (size_t)tr * 256 * 1024, 1024, W + (size_t)tc * 256 * 1024, 1024, 1024, smem, acc, tid);
    ea.o0 = p.R + R_U_OFF; ea.o1 = nullptr;
    gemm_epi<EPI_GELU_U, 4, 8>(p, acc, tr * 256, tc * 256, ea, tid, smem, tid >> 6);
  }
  const int tid2 = opaque_tid(wvs);
  for (int t2 = (blockIdx.x + (gridDim.x >> 1)) % gridDim.x; t2 < 384; t2 += gridDim.x) {
    f32x4 acc[8][4];
    int tc = t2 & 31, tr = t2 >> 5;
    gemm_pipe<2, 4, 8>(W + (size_t)(3072 + tr * 256) * 1024, 1024, p.h + (size_t)tc * 256 * 1024, 1024, 1024, smem, acc, tid2);
    ea.o0 = p.R + R_VT_OFF; ea.o1 = p.stats + (size_t)jl * 48 * 8192 * 2;
    gemm_epi<EPI_GELU_VT, 4, 8>(p, acc, tr * 256, tc * 256, ea, tid2, smem, tid2 >> 6);
  }
}

__device__ __forceinline__ bf16x8 pack8(const f32x16& v, int s) {
  union { uint4 u; bf16x8 b; } x;
  x.u = make_uint4(cvt_pk_bf16(v[8 * s], v[8 * s + 1]), cvt_pk_bf16(v[8 * s + 2], v[8 * s + 3]),
                   cvt_pk_bf16(v[8 * s + 4], v[8 * s + 5]), cvt_pk_bf16(v[8 * s + 6], v[8 * s + 7]));
  return x.b;
}
__device__ __forceinline__ bf16x8 comb(uint2 lo, uint2 hi) {
  union { uint4 u; bf16x8 b; } x;
  x.u = make_uint4(lo.x, lo.y, hi.x, hi.y);
  return x.b;
}

__device__ void attn_phase(const Params& p, char* smem, const int wvs) {
  const int tid0 = opaque_tid(wvs), half = tid0 >> 8, tid = tid0 & 255;
  bf16_t* sK = (bf16_t*)(smem + half * HALF_SMEM);
  bf16_t* sVT = sK + 64 * 72;
  const bf16_t* qkv = (const bf16_t*)(p.R + R_QKV_OFF);
  bf16_t* ao = (bf16_t*)(p.R + R_AO_OFF);
  const int lane = tid & 63, wid = tid >> 6, l31 = lane & 31, hh = lane >> 5;
  for (int u = blockIdx.x * 2 + half; u < 1024; u += gridDim.x * 2) {
    const bool lat = u < 512;
    int b, hq, qb, rowbase;
    if (lat) { b = u >> 7; hq = (u >> 3) & 15; qb = u & 7; rowbase = 4096 + b * 1024; }
    else { int v = u - 512; b = v >> 5; hq = (v >> 1) & 15; qb = v & 1; rowbase = b * 256; }
    const int kvh = hq >> 2;
    const int qloc = qb * 128 + wid * 32 + l31;
    bf16x8 qf[4];
    {
      const bf16_t* qp = qkv + (size_t)(rowbase + qloc) * 1536 + hq * 64 + hh * 8;
#pragma unroll
      for (int s = 0; s < 4; ++s) qf[s] = *(const bf16x8*)(qp + 16 * s);
    }
    float m_run = p.attn_sink[hq] * 1.4426950408889634f, l_run = 1.f;
    f32x16 O[2];
#pragma unroll
    for (int r = 0; r < 16; ++r) { O[0][r] = 0.f; O[1][r] = 0.f; }
    const int ntiles = lat ? 10 : 4;
    for (int it = 0; it < ntiles; ++it) {
      int kpos0; bool fromcache = false, local = false, skip = false;
      if (lat) {
        if (it < 6) { kpos0 = qb * 128 - 128 + it * 64; local = true; skip = (kpos0 < 0 || kpos0 >= 1024); }
        else { fromcache = true; kpos0 = (it - 6) * 64; }
      } else kpos0 = it * 64;
      __syncthreads();
      if (!skip) {
        const int key = tid >> 2, ds = (tid & 3) * 16;
        unsigned kw[8], vw[8];
        if (fromcache) {
          const float* kp = p.cache_k + (((size_t)b * 256 + kpos0 + key) * 4 + kvh) * 64 + ds;
          const float* vp = p.cache_v + (((size_t)b * 256 + kpos0 + key) * 4 + kvh) * 64 + ds;
#pragma unroll
          for (int e = 0; e < 4; ++e) {
            float4 a = *(const float4*)(kp + 4 * e), c = *(const float4*)(vp + 4 * e);
            kw[2 * e] = cvt_pk_bf16(a.x, a.y); kw[2 * e + 1] = cvt_pk_bf16(a.z, a.w);
            vw[2 * e] = cvt_pk_bf16(c.x, c.y); vw[2 * e + 1] = cvt_pk_bf16(c.z, c.w);
          }
        } else {
          const bf16_t* kp = qkv + (size_t)(rowbase + kpos0 + key) * 1536 + 1024 + kvh * 64 + ds;
          uint4 a0 = *(const uint4*)kp, a1 = *(const uint4*)(kp + 8);
          uint4 c0 = *(const uint4*)(kp + 256), c1 = *(const uint4*)(kp + 264);
          kw[0] = a0.x; kw[1] = a0.y; kw[2] = a0.z; kw[3] = a0.w; kw[4] = a1.x; kw[5] = a1.y; kw[6] = a1.z; kw[7] = a1.w;
          vw[0] = c0.x; vw[1] = c0.y; vw[2] = c0.z; vw[3] = c0.w; vw[4] = c1.x; vw[5] = c1.y; vw[6] = c1.z; vw[7] = c1.w;
        }
        *(uint4*)(sK + key * 72 + ds) = make_uint4(kw[0], kw[1], kw[2], kw[3]);
        *(uint4*)(sK + key * 72 + ds + 8) = make_uint4(kw[4], kw[5], kw[6], kw[7]);
#pragma unroll
        for (int e = 0; e < 8; ++e) {
          sVT[(ds + 2 * e) * 72 + key] = (bf16_t)(vw[e] & 0xffffu);
          sVT[(ds + 2 * e + 1) * 72 + key] = (bf16_t)(vw[e] >> 16);
        }
      }
      __syncthreads();
      if (!skip) {
      f32x16 st[2];
#pragma unroll
      for (int t = 0; t < 2; ++t) {
        f32x16 a;
#pragma unroll
        for (int r = 0; r < 16; ++r) a[r] = 0.f;
#pragma unroll
        for (int s = 0; s < 4; ++s) {
          bf16x8 kf = *(const bf16x8*)(sK + (32 * t + l31) * 72 + 16 * s + 8 * hh);
          a = __builtin_amdgcn_mfma_f32_32x32x16_bf16(kf, qf[s], a, 0, 0, 0);
        }
        st[t] = a;
      }
      float mx = -1e30f;
#pragma unroll
      for (int t = 0; t < 2; ++t)
#pragma unroll
        for (int r = 0; r < 16; ++r) {
          float s = st[t][r] * (0.125f * 1.4426950408889634f);
          if (local) {
            int key = kpos0 + 32 * t + (r & 3) + 8 * (r >> 2) + 4 * hh;
            int d = qloc - key;
            if (d > 128 || d < -128) s = -1e30f;
          }
          st[t][r] = s;
          mx = fmaxf(mx, s);
        }
      mx = fmaxf(mx, __shfl_xor(mx, 32));
      float mn = fmaxf(m_run, mx);
      float alpha = __builtin_amdgcn_exp2f(m_run - mn);
      float ps = 0.f;
#pragma unroll
      for (int t = 0; t < 2; ++t)
#pragma unroll
        for (int r = 0; r < 16; ++r) { float pv = __builtin_amdgcn_exp2f(st[t][r] - mn); st[t][r] = pv; ps += pv; }
      ps += __shfl_xor(ps, 32);
      l_run = l_run * alpha + ps; m_run = mn;
#pragma unroll
      for (int r = 0; r < 16; ++r) { O[0][r] *= alpha; O[1][r] *= alpha; }
#pragma unroll
      for (int t = 0; t < 2; ++t)
#pragma unroll
        for (int s2 = 0; s2 < 2; ++s2) {
          bf16x8 pf = pack8(st[t], s2);
#pragma unroll
          for (int dt = 0; dt < 2; ++dt) {
            const bf16_t* vp = sVT + (32 * dt + l31) * 72 + 32 * t + 16 * s2 + 4 * hh;
            bf16x8 vf = comb(*(const uint2*)vp, *(const uint2*)(vp + 8));
            O[dt] = __builtin_amdgcn_mfma_f32_32x32x16_bf16(vf, pf, O[dt], 0, 0, 0);
          }
        }
      }
    }
    const float inv = 1.f / l_run;
    bf16_t* op = ao + (size_t)(rowbase + qloc) * 1024 + hq * 64 + 4 * hh;
#pragma unroll
    for (int dt = 0; dt < 2; ++dt)
#pragma unroll
      for (int k = 0; k < 4; ++k)
        *(uint2*)(op + 32 * dt + 8 * k) = make_uint2(cvt_pk_bf16(O[dt][4 * k] * inv, O[dt][4 * k + 1] * inv),
                                                     cvt_pk_bf16(O[dt][4 * k + 2] * inv, O[dt][4 * k + 3] * inv));
  }
}

__device__ void conv_phase(const Params& p, const int wvs) {
  const bf16_t* zx = (const bf16_t*)(p.R + R_ZX_OFF);
  bf16_t* xc = (bf16_t*)(p.R + R_XC_OFF);
  const int tid = opaque_tid(wvs);
  for (int base = blockIdx.x * NTHR; base < 8192 * 384; base += gridDim.x * NTHR) {
    const int i = base + tid;
    int row = i / 384, cg8 = (i - row * 384) * 8;
    int s, T;
    if (row < 4096) { s = row & 255; T = 256; } else { s = (row - 4096) & 1023; T = 1024; }
    const bf16_t* src = zx + (size_t)row * 5120 + 2048 + cg8;
    uint4 c = *(const uint4*)src, a = make_uint4(0, 0, 0, 0), n = make_uint4(0, 0, 0, 0);
    if (s > 0) a = *(const uint4*)(src - 5120);
    if (s < T - 1) n = *(const uint4*)(src + 5120);
    unsigned aw[4] = {a.x, a.y, a.z, a.w}, cw[4] = {c.x, c.y, c.z, c.w}, nw[4] = {n.x, n.y, n.z, n.w}, o[4];
#pragma unroll
    for (int e = 0; e < 4; ++e) {
      int ch = cg8 + 2 * e;
      float w00 = p.ssm_conv_w[ch], w01 = p.ssm_conv_w[3072 + ch], w02 = p.ssm_conv_w[6144 + ch], b0 = p.ssm_conv_b[ch];
      float w10 = p.ssm_conv_w[ch + 1], w11 = p.ssm_conv_w[3072 + ch + 1], w12 = p.ssm_conv_w[6144 + ch + 1], b1 = p.ssm_conv_b[ch + 1];
      float y0 = b0 + w00 * lo_f(aw[e]) + w01 * lo_f(cw[e]) + w02 * lo_f(nw[e]);
      float y1 = b1 + w10 * hi_f(aw[e]) + w11 * hi_f(cw[e]) + w12 * hi_f(nw[e]);
      o[e] = cvt_pk_bf16(silu_f(y0), silu_f(y1));
    }
    *(uint4*)(xc + (size_t)row * 3072 + cg8) = make_uint4(o[0], o[1], o[2], o[3]);
  }
}

__device__ void ssd_phase(const Params& p, char* smem, const int wvs) {
  const int tid0 = opaque_tid(wvs), half = tid0 >> 8, tid = tid0 & 255;
  bf16_t* sXT = (bf16_t*)(smem + half * HALF_SMEM);
  bf16_t* sBT = sXT + 64 * 136;
  bf16_t* sH = sBT + 128 * 136;
  float* sAc = (float*)(sH + 64 * 136);
  float* sDt = sAc + 128;
  const bf16_t* xc = (const bf16_t*)(p.R + R_XC_OFF);
  const float* dtb = (const float*)(p.R + R_DT_OFF);
  bf16_t* yb = (bf16_t*)(p.R + R_Y_OFF);
  const int lane = tid & 63, wid = tid >> 6, l31 = lane & 31, hh = lane >> 5;
  for (int w = blockIdx.x * 2 + half; w < 512; w += gridDim.x * 2)
  for (int sub = 0; sub < (w < 256 ? 1 : 4); ++sub) {
    const bool lat = w < 256;
    int b, dir, h, rowbase, T, nch;
    if (lat) { int u = w; b = u >> 6; dir = (u >> 5) & 1; h = u & 31; rowbase = 4096 + b * 1024; T = 1024; nch = 8; }
    else { int v = (w - 256) * 4 + sub; b = v >> 6; dir = (v >> 5) & 1; h = v & 31; rowbase = b * 256; T = 256; nch = 2; }
    const int g = h >> 3;
    const float a = -expf(p.ssm_a_log[dir * 32 + h]) * 1.4426950408889634f;
    const int ncol = 32 * wid + l31;
    f32x16 st[2];
    if (lat) {
      const float* h0 = p.state_ssm + (((size_t)b * 2 + dir) * 32 + h) * 64 * 128;
#pragma unroll
      for (int pt = 0; pt < 2; ++pt)
#pragma unroll
        for (int r = 0; r < 16; ++r) st[pt][r] = h0[(size_t)(32 * pt + (r & 3) + 8 * (r >> 2) + 4 * hh) * 128 + ncol];
    } else {
#pragma unroll
      for (int r = 0; r < 16; ++r) { st[0][r] = 0.f; st[1][r] = 0.f; }
    }
    for (int c = 0; c < nch; ++c) {
#define ROWOF(i) ((size_t)(rowbase + (dir ? (T - 1 - (c * 128 + (i))) : (c * 128 + (i)))))
      __syncthreads();
      const int myi = ncol;
      const size_t myrow = ROWOF(myi);
      bf16x8 cf[8];
#pragma unroll
      for (int s = 0; s < 8; ++s) cf[s] = *(const bf16x8*)(xc + myrow * 3072 + 2560 + g * 128 + 16 * s + 8 * hh);
      float dtv = 0.f;
      if (tid < 128) dtv = dtb[ROWOF(tid) * 64 + dir * 32 + h];
      uint4 xr[4], br[8];
      {
        const int i = tid >> 1;
        const uint4* srcx = (const uint4*)(xc + ROWOF(i) * 3072 + h * 64 + (tid & 1) * 32);
        const uint4* srcb = (const uint4*)(xc + ROWOF(i) * 3072 + 2048 + g * 128 + (tid & 1) * 64);
#pragma unroll
        for (int q = 0; q < 4; ++q) xr[q] = srcx[q];
#pragma unroll
        for (int q = 0; q < 8; ++q) br[q] = srcb[q];
      }
#pragma unroll
      for (int pt = 0; pt < 2; ++pt)
#pragma unroll
        for (int r = 0; r < 16; ++r) sH[(32 * pt + (r & 3) + 8 * (r >> 2) + 4 * hh) * 136 + ncol] = f2bf_hw(st[pt][r]);
      if (tid < 128) {
        float v = a * dtv;
#pragma unroll
        for (int o = 1; o < 64; o <<= 1) { float t = __shfl_up(v, o); if (lane >= o) v += t; }
        sAc[tid] = v; sDt[tid] = dtv;
      }
      {
        const int i = tid >> 1, ps = (tid & 1) * 32;
#pragma unroll
        for (int q = 0; q < 4; ++q) {
          unsigned w[4] = {xr[q].x, xr[q].y, xr[q].z, xr[q].w};
#pragma unroll
          for (int e = 0; e < 4; ++e) {
            sXT[(ps + q * 8 + 2 * e) * 136 + i] = (bf16_t)(w[e] & 0xffffu);
            sXT[(ps + q * 8 + 2 * e + 1) * 136 + i] = (bf16_t)(w[e] >> 16);
          }
        }
      }
      {
        const int j = tid >> 1, ns = (tid & 1) * 64;
#pragma unroll
        for (int q = 0; q < 8; ++q) *(uint4*)(sBT + j * 136 + ns + q * 8) = br[q];
      }
      __syncthreads();
      if (tid >= 64 && tid < 128) sAc[tid] += sAc[63];
      __syncthreads();
      const float alast = sAc[127];
      const float aci = sAc[myi];
      f32x16 Y[2];
#pragma unroll
      for (int r = 0; r < 16; ++r) { Y[0][r] = 0.f; Y[1][r] = 0.f; }
#pragma unroll
      for (int s = 0; s < 8; ++s)
#pragma unroll
        for (int pt = 0; pt < 2; ++pt) {
          bf16x8 hf = *(const bf16x8*)(sH + (32 * pt + l31) * 136 + 16 * s + 8 * hh);
          Y[pt] = __builtin_amdgcn_mfma_f32_32x32x16_bf16(hf, cf[s], Y[pt], 0, 0, 0);
        }
      {
        const float ei = __builtin_amdgcn_exp2f(aci);
#pragma unroll
        for (int r = 0; r < 16; ++r) { Y[0][r] *= ei; Y[1][r] *= ei; }
      }
      for (int jt = 0; jt <= wid; ++jt) {
        f32x16 G;
#pragma unroll
        for (int r = 0; r < 16; ++r) G[r] = 0.f;
#pragma unroll
        for (int s = 0; s < 8; ++s) {
          const bf16x8 bf = *(const bf16x8*)(sBT + (32 * jt + l31) * 136 + 16 * s + 8 * hh);
          G = __builtin_amdgcn_mfma_f32_32x32x16_bf16(bf, cf[s], G, 0, 0, 0);
        }
#pragma unroll
        for (int r = 0; r < 16; ++r) {
          int j = 32 * jt + (r & 3) + 8 * (r >> 2) + 4 * hh;
          float w = G[r] * __builtin_amdgcn_exp2f(fminf(aci - sAc[j], 0.f)) * sDt[j];
          G[r] = (j <= myi) ? w : 0.f;
        }
#pragma unroll
        for (int s2 = 0; s2 < 2; ++s2) {
          bf16x8 wf = pack8(G, s2);
#pragma unroll
          for (int pt = 0; pt < 2; ++pt) {
            const bf16_t* xp = sXT + (32 * pt + l31) * 136 + 32 * jt + 16 * s2 + 4 * hh;
            bf16x8 xf = comb(*(const uint2*)xp, *(const uint2*)(xp + 8));
            Y[pt] = __builtin_amdgcn_mfma_f32_32x32x16_bf16(xf, wf, Y[pt], 0, 0, 0);
          }
        }
      }
      {
        bf16_t* op = yb + ((size_t)dir * 8192 + myrow) * 2048 + h * 64 + 4 * hh;
#pragma unroll
        for (int pt = 0; pt < 2; ++pt)
#pragma unroll
          for (int k = 0; k < 4; ++k)
            *(uint2*)(op + 32 * pt + 8 * k) = make_uint2(cvt_pk_bf16(Y[pt][4 * k], Y[pt][4 * k + 1]), cvt_pk_bf16(Y[pt][4 * k + 2], Y[pt][4 * k + 3]));
      }
      __syncthreads();
      {
        const int j = tid >> 1, ns = (tid & 1) * 64;
        const float sc = sDt[j] * __builtin_amdgcn_exp2f(alast - sAc[j]);
#pragma unroll
        for (int q = 0; q < 8; ++q) {
          unsigned w[4] = {br[q].x, br[q].y, br[q].z, br[q].w};
#pragma unroll
          for (int e = 0; e < 4; ++e) {
            sBT[(ns + q * 8 + 2 * e) * 136 + j] = f2bf_hw(lo_f(w[e]) * sc);
            sBT[(ns + q * 8 + 2 * e + 1) * 136 + j] = f2bf_hw(hi_f(w[e]) * sc);
          }
        }
      }
      __syncthreads();
      {
        const float el = __builtin_amdgcn_exp2f(alast);
#pragma unroll
        for (int r = 0; r < 16; ++r) { st[0][r] *= el; st[1][r] *= el; }
      }
#pragma unroll
      for (int s = 0; s < 8; ++s) {
        bf16x8 bfr = *(const bf16x8*)(sBT + (32 * wid + l31) * 136 + 16 * s + 8 * hh);
#pragma unroll
        for (int pt = 0; pt < 2; ++pt) {
          bf16x8 xf = *(const bf16x8*)(sXT + (32 * pt + l31) * 136 + 16 * s + 8 * hh);
          st[pt] = __builtin_amdgcn_mfma_f32_32x32x16_bf16(xf, bfr, st[pt], 0, 0, 0);
        }
      }
#undef ROWOF
    }
    if (!lat) {
      float* so = p.out + 10485760 + (((size_t)b * 2 + dir) * 32 + h) * 64 * 128;
#pragma unroll
      for (int pt = 0; pt < 2; ++pt)
#pragma unroll
        for (int r = 0; r < 16; ++r) so[(size_t)(32 * pt + (r & 3) + 8 * (r >> 2) + 4 * hh) * 128 + ncol] = st[pt][r];
    }
  }
}

__device__ void ssm_post_phase(const Params& p, const int wvs) {
  const bf16_t* zx = (const bf16_t*)(p.R + R_ZX_OFF);
  const bf16_t* xc = (const bf16_t*)(p.R + R_XC_OFF);
  const bf16_t* yb = (const bf16_t*)(p.R + R_Y_OFF);
  bf16_t* yn = p.hid;
  const int tid = opaque_tid(wvs); const int lane = tid & 63, wid = tid >> 6;
  for (int row = blockIdx.x * 8 + wid; row < 8192; row += gridDim.x * 8) {
    float y[32];
    float ss = 0.f;
#pragma unroll
    for (int i = 0; i < 4; ++i) {
      int col = (i * 64 + lane) * 8;
      uint4 f = *(const uint4*)(yb + (size_t)row * 2048 + col);
      uint4 bk = *(const uint4*)(yb + ((size_t)8192 + row) * 2048 + col);
      uint4 xs = *(const uint4*)(xc + (size_t)row * 3072 + col);
      uint4 z = *(const uint4*)(zx + (size_t)row * 5120 + col);
      float d = p.ssm_d[col >> 6];
      unsigned fw[4] = {f.x, f.y, f.z, f.w}, bw[4] = {bk.x, bk.y, bk.z, bk.w}, xw[4] = {xs.x, xs.y, xs.z, xs.w}, zw[4] = {z.x, z.y, z.z, z.w};
#pragma unroll
      for (int e = 0; e < 4; ++e) {
        float v0 = (lo_f(fw[e]) + lo_f(bw[e]) + d * lo_f(xw[e])) * silu_f(lo_f(zw[e]));
        float v1 = (hi_f(fw[e]) + hi_f(bw[e]) + d * hi_f(xw[e])) * silu_f(hi_f(zw[e]));
        y[i * 8 + 2 * e] = v0; y[i * 8 + 2 * e + 1] = v1;
        ss += v0 * v0 + v1 * v1;
      }
    }
#pragma unroll
    for (int o = 32; o > 0; o >>= 1) ss += __shfl_xor(ss, o);
    float rstd = rsqrtf(ss * (1.f / 2048.f) + 1e-6f);
#pragma unroll
    for (int i = 0; i < 4; ++i) {
      int col = (i * 64 + lane) * 8;
      float4 g0 = *(const float4*)(p.ssm_norm + col), g1 = *(const float4*)(p.ssm_norm + col + 4);
      *(uint4*)(yn + (size_t)row * 2048 + col) =
          make_uint4(cvt_pk_bf16(y[i * 8] * rstd * g0.x, y[i * 8 + 1] * rstd * g0.y), cvt_pk_bf16(y[i * 8 + 2] * rstd * g0.z, y[i * 8 + 3] * rstd * g0.w),
                     cvt_pk_bf16(y[i * 8 + 4] * rstd * g1.x, y[i * 8 + 5] * rstd * g1.y), cvt_pk_bf16(y[i * 8 + 6] * rstd * g1.z, y[i * 8 + 7] * rstd * g1.w));
    }
  }
}


#define XB_TMO      128
#define XB_XCNT(j)  (256  + 64 * (j))
#define XB_XSUB(j)  (1280 + 64 * (j))
#define XB_XGEN(j)  (2304 + 64 * (j))
#define XB_TOP      3328
#define XB_TOPGEN   3392
#define XCD_BAR_WORDS 3456
#define XB_SPIN_CAP (1u << 18)
#define LAS __attribute__((address_space(3)))

__device__ __forceinline__ unsigned xb_ld(unsigned* p)              { return __hip_atomic_load(p, __ATOMIC_RELAXED, __HIP_MEMORY_SCOPE_AGENT); }
__device__ __forceinline__ unsigned xb_add(unsigned* p, unsigned v) { return __hip_atomic_fetch_add(p, v, __ATOMIC_RELAXED, __HIP_MEMORY_SCOPE_AGENT); }
__device__ __forceinline__ unsigned xb_xcc_id() { return (unsigned)__builtin_amdgcn_s_getreg((3 << 11) | 20) & 0xFu; }
#define XB_SPIN(cond, bar) do { unsigned _sp = 0; while (cond) { __builtin_amdgcn_s_sleep(1); \
    if ((++_sp & 255u) == 0u) { if (xb_ld(&(bar)[XB_TMO])) break; if (_sp > XB_SPIN_CAP) { atomicAdd(&(bar)[XB_TMO], 1u); break; } } } } while (0)

struct XcdBarrier { unsigned* bar; unsigned x; volatile LAS unsigned* st; };

__device__ __forceinline__ XcdBarrier xcd_barrier_post(unsigned* bar, volatile LAS unsigned* st) {
  XcdBarrier b; b.bar = bar; b.x = xb_xcc_id(); b.st = st;
  if (threadIdx.x == 0) (void)xb_add(&bar[XB_XCNT(b.x)], 1u);
  return b;
}
__device__ __forceinline__ void xcd_barrier_complete(unsigned* bar, unsigned x, unsigned& nloc, unsigned& nx) {
  const unsigned G = gridDim.x * gridDim.y * gridDim.z;
  unsigned sum, cnt, mine, sp = 0u;
  for (;;) {
    sum = 0u; cnt = 0u; mine = 0u;
#pragma unroll
    for (unsigned j = 0; j < 16; ++j) { const unsigned c = xb_ld(&bar[XB_XCNT(j)]); sum += c; cnt += (c > 0u) ? 1u : 0u; mine = (j == x) ? c : mine; }
    if (sum == G) break;
    __builtin_amdgcn_s_sleep(1);
    if ((++sp & 255u) == 0u) { if (xb_ld(&bar[XB_TMO])) break; if (sp > XB_SPIN_CAP) { atomicAdd(&bar[XB_TMO], 1u); break; } }
  }
  nloc = mine > 0u ? mine : 1u; nx = cnt > 0u ? cnt : 1u;
}
__device__ __forceinline__ void xcd_barrier(const XcdBarrier& b, const int wvs) {
  asm volatile("s_waitcnt vmcnt(0)" ::: "memory");
  __syncthreads();
  if (opaque_tid(wvs) == 0) {
    unsigned* bar = b.bar;
    __builtin_amdgcn_s_waitcnt(0);
    unsigned nloc = b.st[0], nx = b.st[1];
    if (nloc == 0u) { xcd_barrier_complete(bar, b.x, nloc, nx); b.st[0] = nloc; b.st[1] = nx; }
    const unsigned old = xb_add(&bar[XB_XSUB(b.x)], 1u);
    const unsigned gen = old / nloc;
    if (old + 1u == (gen + 1u) * nloc) {
      __builtin_amdgcn_fence(__ATOMIC_RELEASE, "agent");
      asm volatile("s_waitcnt vmcnt(0)" ::: "memory");
      const unsigned og = xb_add(&bar[XB_TOP], 1u);
      const unsigned tg = og / nx;
      if (og + 1u == (tg + 1u) * nx) xb_add(&bar[XB_TOPGEN], 1u);
      else XB_SPIN(xb_ld(&bar[XB_TOPGEN]) == tg, bar);
      __builtin_amdgcn_fence(__ATOMIC_ACQUIRE, "agent");
      xb_add(&bar[XB_XGEN(b.x)], 1u);
      asm volatile("s_waitcnt vmcnt(0)" ::: "memory");
    } else {
      XB_SPIN(xb_ld(&bar[XB_XGEN(b.x)]) == gen, bar);
      __builtin_amdgcn_fence(__ATOMIC_ACQUIRE, "agent");
      asm volatile("s_waitcnt vmcnt(0)" ::: "memory");
    }
  }
  __syncthreads();
}

enum { PH_PREP = 0, PH_ROW_A, PH_ROW_B, PH_ROW_C, PH_ROW_F, PH_SWIGLU, PH_FFNOUT, PH_GM_IN, PH_GM_SP, PH_GM_OUT, PH_GM_LN,
       PH_QKV, PH_ATT, PH_AT_OUT, PH_SS_IN, PH_CONV, PH_SSD, PH_POST, PH_SS_OUT };

__device__ __forceinline__ void decode_phase(int ph, int& type, int& l, int& half) {
  l = 0; half = 0;
  if (ph == 0) { type = PH_PREP; return; }
  if (ph >= 43) { type = PH_ROW_F; return; }
  int q = ph - 1;
  if (q >= 32) { l = 3; q -= 32; } else if (q >= 20) { l = 2; q -= 20; } else if (q >= 10) { l = 1; q -= 10; }
  const int kind = l % 3;
  const int nm = kind == 0 ? 3 : (kind == 1 ? 3 : 5);
  if (q == 0) { type = PH_ROW_A; return; }
  if (q == 1) { type = PH_SWIGLU; return; }
  if (q == 2) { type = PH_FFNOUT; return; }
  if (q == 3) { type = PH_ROW_B; return; }
  if (q < 4 + nm) {
    int m = q - 4;
    type = kind == 0 ? PH_GM_IN + m : (kind == 1 ? PH_QKV + m : PH_SS_IN + m);
    return;
  }
  q -= 4 + nm; half = 1;
  type = q == 0 ? PH_ROW_C : (q == 1 ? PH_SWIGLU : PH_FFNOUT);
}

__global__ void __launch_bounds__(NTHR, 2) fwd_kernel(Params p, int pb, int pe) {
  __shared__ __attribute__((aligned(16))) char smem[SMEM_BYTES];
  cg::grid_group grid = cg::this_grid();
  const int wvs = __builtin_amdgcn_readfirstlane((int)(threadIdx.x >> 6));
  volatile LAS unsigned* xbw = (volatile LAS unsigned*)(smem + SMEM_BYTES - 16);
  if (threadIdx.x < 4) xbw[threadIdx.x] = 0u;
  __syncthreads();
  XcdBarrier xb = xcd_barrier_post(p.bar, xbw);
#pragma unroll 1
  for (int ph = pb; ph < pe; ++ph) {
    int type, l, half;
    decode_phase(ph, type, l, half);
    const int jl = l / 3;
    const float* ng = p.norm_g + (size_t)l * 6 * 1024;
    EA ea; ea.o0 = ea.o1 = nullptr; ea.a0 = ea.a1 = nullptr; ea.i0 = ea.i1 = ea.i2 = ea.i3 = 0;
#if REPEAT_MASK
    const int nrep = ((REPEAT_MASK >> type) & 1) ? 2 : 1;
    for (int rep = 0; rep < nrep; ++rep) {
#endif
    switch (type) {
      case PH_PREP: prep_phase(p, smem, wvs); break;
      case PH_ROW_A: case PH_ROW_B: case PH_ROW_C: case PH_ROW_F: {
        bool first = false, has_f = true, has_next = true;
        int gl = l, gslot = 2, shslot = 3, scslot = 4;
        float coef = 0.5f;
        const float* gf = ng + 1 * 1024; const float* gn = ng + 2 * 1024;
        if (type == PH_ROW_A) { first = l == 0; has_f = l > 0; gl = l - 1; gslot = 8; gf = ng - 1024; gn = ng; shslot = 0; scslot = 1; }
        else if (type == PH_ROW_C) { gslot = 5; coef = 1.0f; gf = ng + 3 * 1024; gn = ng + 4 * 1024; shslot = 6; scslot = 7; }
        else if (type == PH_ROW_F) { gl = 3; gslot = 8; gf = p.norm_g + (size_t)(3 * 6 + 5) * 1024; has_next = false; }
        rowop_phase(p, first, has_f, gl, gslot, coef, gf, has_next, l, gn, shslot, scslot, wvs);
      } break;
      case PH_SWIGLU:
        ea.o0 = p.hid;
        gemm_phase<EPI_SWIGLU, 2, 4, 8>(p, p.h, 1024, p.wt_ffn_in + (size_t)(l * 2 + half) * 5632 * 1024, 1024, 1024, 32, 22, smem, ea, wvs);
        break;
      case PH_FFNOUT: case PH_GM_OUT: case PH_AT_OUT: case PH_SS_OUT: {
        const bf16_t* A; const bf16_t* B; int K;
        if (type == PH_FFNOUT) { A = p.hid; B = p.wt_ffn_out + (size_t)(l * 2 + half) * 1024 * 2816; K = 2816; }
        else if (type == PH_GM_OUT) { A = (const bf16_t*)(p.R + R_GATED_OFF); B = p.wt_gmlp_out + (size_t)jl * 1024 * 3072; K = 3072; }
        else if (type == PH_AT_OUT) { A = (const bf16_t*)(p.R + R_AO_OFF); B = p.wt_ao; K = 1024; }
        else { A = p.hid; B = p.wt_ssm_out; K = 2048; }
        gemm_splitk_phase(p, A, B, K, smem, wvs);
      } break;
      case PH_GM_IN: gmlp_in_phase(p, jl, smem, wvs); break;
      case PH_GM_LN: gmlp_ln_phase(p, jl, smem, wvs); break;
      case PH_GM_SP: gmlp_spatial_phase(p, jl, smem, wvs); break;
      case PH_QKV:
        ea.o0 = p.R + R_QKV_OFF;
        gemm_phase<EPI_QKV, 4, 2, 4>(p, p.h, 1024, p.wt_qkv, 1024, 1024, 32, 12, smem, ea, wvs);
        break;
      case PH_ATT: attn_phase(p, smem, wvs); break;
      case PH_SS_IN:
        ea.o0 = p.R + R_ZX_OFF; ea.o1 = p.R + R_DT_OFF;
        gemm_phase<EPI_SSMIN, 2, 4, 8>(p, p.h, 1024, p.wt_ssm_in, 1024, 1024, 32, 21, smem, ea, wvs);
        break;
      case PH_CONV: conv_phase(p, wvs); break;
      case PH_SSD: ssd_phase(p, smem, wvs); break;
      case PH_POST: ssm_post_phase(p, wvs); break;
      default: break;
    }
#if REPEAT_MASK
    }
#endif
#if EXTRA_SYNCS
    for (int k = 0; k < EXTRA_SYNCS; ++k) xcd_barrier(xb, wvs);
#endif
    if (ph + 1 < pe) { if (pe < 0) grid.sync(); else xcd_barrier(xb, wvs); }
  }
}

#define N_PHASES 44

extern "C" void kernel_launch(void* const* d_in, const int* in_sizes, int n_in, void* d_out, int out_size, void* d_ws,
                              size_t ws_size, hipStream_t stream) {
  Params p{};
  const float* const* in = (const float* const*)d_in;
  p.x_prompt = in[0]; p.x_sample = in[1]; p.cache_k = in[2]; p.cache_v = in[3]; p.state_ssm = in[4]; p.c = in[5]; p.c_ctx = in[6];
  p.w_mod = in[7]; p.b_mod = in[8]; p.norm_g = in[9]; p.ffn_in = in[10]; p.ffn_out = in[11];
  p.gmlp_in = in[12]; p.gmlp_ln_g = in[13]; p.gmlp_ln_b = in[14]; p.gmlp_ws = in[15]; p.gmlp_bs = in[16]; p.gmlp_out = in[17];
  p.attn_qkv = in[18]; p.attn_sink = in[19]; p.attn_out = in[20];
  p.ssm_in = in[21]; p.ssm_conv_w = in[22]; p.ssm_conv_b = in[23]; p.ssm_dt_bias = in[24]; p.ssm_a_log = in[25];
  p.ssm_d = in[26]; p.ssm_norm = in[27]; p.ssm_out = in[28];
  p.out = (float*)d_out;
  char* w = (char*)d_ws;
  size_t off = 0;
  auto take = [&](size_t bytes) { char* r = w + off; off += (bytes + 255) & ~(size_t)255; return r; };
  p.wt_ffn_in = (bf16_t*)take(8ull * 5632 * 1024 * 2);
  p.wt_ffn_out = (bf16_t*)take(8ull * 1024 * 2816 * 2);
  p.wt_gmlp_in = (bf16_t*)take(2ull * 6144 * 1024 * 2);
  p.wt_gmlp_out = (bf16_t*)take(2ull * 1024 * 3072 * 2);
  p.wt_qkv = (bf16_t*)take(1536ull * 1024 * 2);
  p.wt_ao = (bf16_t*)take(1024ull * 1024 * 2);
  p.wt_ssm_in = (bf16_t*)take(5376ull * 1024 * 2);
  p.wt_ssm_out = (bf16_t*)take(1024ull * 2048 * 2);
  p.ws_bf = (bf16_t*)take(2ull * 8 * 128 * 128 * 2);
  p.mod = (float*)take(4ull * 5 * 9216 * 4);
  p.x = (float*)take(8192ull * 1024 * 4);
  p.f = (float*)take(8192ull * 1024 * 4);
  p.stats = (float*)take(2ull * 48 * 8192 * 2 * 4);
  p.h = (bf16_t*)take(8192ull * 1024 * 2);
  p.hid = (bf16_t*)take(8192ull * 2816 * 2);
  p.R = take(R_BYTES);
  p.bar = (unsigned*)take(XCD_BAR_WORDS * 4);
  if (off > ws_size) { fprintf(stderr, "workspace too small: need %zu have %zu\n", off, ws_size); return; }

  hipMemsetAsync(p.bar, 0, XCD_BAR_WORDS * 4, stream);
#if ONE_LAUNCH
  static int grid_blocks = 0;
  if (!grid_blocks) {
    int dev = 0, cus = 0, per_cu = 0;
    hipGetDevice(&dev);
    hipDeviceGetAttribute(&cus, hipDeviceAttributeMultiprocessorCount, dev);
    hipOccupancyMaxActiveBlocksPerMultiprocessor(&per_cu, fwd_kernel, NTHR, 0);
    per_cu = 1;
    grid_blocks = cus * per_cu;
  }
  int pb = 0, pe = N_PHASES;
  void* args[] = {&p, &pb, &pe};
  hipError_t e = hipLaunchCooperativeKernel((void*)fwd_kernel, dim3(grid_blocks), dim3(NTHR), args, 0, stream);
  if (e != hipSuccess) fprintf(stderr, "cooperative launch failed: %s (grid %d)\n", hipGetErrorString(e), grid_blocks);
#else
  for (int ph = 0; ph < N_PHASES; ++ph) fwd_kernel<<<256, NTHR, 0, stream>>>(p, ph, ph + 1);
#endif
}
```
